# Optimizing an MI355X kernel written in HIP

```python
import jax, jax.numpy as jnp
from jax import lax
import numpy as np

D_MODEL = 1024
BATCH = 2
SEQ = 8192
DEPTH = 4

CHUNK = 64
N_MIXERS = 2
GLA_HEADS = 4
GLA_DK = D_MODEL // 2
GLA_DV = D_MODEL
GLA_DK_HEAD = GLA_DK // GLA_HEADS
GLA_DV_HEAD = GLA_DV // GLA_HEADS
GLA_GATE_RANK = 16
GLA_GATE_TAU = 16.0
GLA_IN_WIDTH = 2 * GLA_DK + 2 * GLA_DV + GLA_GATE_RANK
ATT_HEADS = 16
ATT_HEAD_DIM = D_MODEL // ATT_HEADS
LEFT_CHUNKS = 8
BAND = (LEFT_CHUNKS + 1) * CHUNK
MAX_REL = 128
N_REL = 2 * MAX_REL + 1
D_FF = 4 * D_MODEL
DEEPNORM_ALPHA = (2.0 * DEPTH) ** 0.25
DEEPNORM_BETA = (8.0 * DEPTH) ** -0.25
LN_EPS = 1e-5
RMS_EPS = 1e-6
NEG_INF = -1e30
N_GLA_LAYERS = (DEPTH + 1) // 2
N_ATT_LAYERS = DEPTH // 2

kernel_name = "hybrid_gla_chunkattn_deepnorm_adaln"


def layer_norm(x, g, b):
    xf = x.astype(jnp.float32)
    mu = jnp.mean(xf, -1, keepdims=True)
    var = jnp.mean(jnp.square(xf - mu), -1, keepdims=True)
    return ((xf - mu) * lax.rsqrt(var + LN_EPS)).astype(x.dtype) * g + b


def gla_mixer(u, w_in, w_gk2, b_gk, g_norm, w_out):
    B_, S_, _ = u.shape
    nC = S_ // CHUNK
    proj = u @ w_in
    q, k, v, g, gk_lr = jnp.split(
        proj, [GLA_DK, 2 * GLA_DK, 2 * GLA_DK + GLA_DV, 2 * GLA_DK + 2 * GLA_DV], axis=-1)
    log_a = jax.nn.log_sigmoid((gk_lr @ w_gk2 + b_gk).astype(jnp.float32)) / GLA_GATE_TAU

    def to_chunks(t, hd):
        return t.reshape(B_, nC, CHUNK, GLA_HEADS, hd).transpose(0, 3, 1, 2, 4)

    qc = to_chunks(q.astype(jnp.float32), GLA_DK_HEAD) * (GLA_DK_HEAD ** -0.5)
    kc = to_chunks(k.astype(jnp.float32), GLA_DK_HEAD)
    vc = to_chunks(v.astype(jnp.float32), GLA_DV_HEAD)
    cum = jnp.cumsum(to_chunks(log_a, GLA_DK_HEAD), axis=3)
    e_pos = jnp.exp(cum)
    e_neg = jnp.exp(-cum)
    q_fwd = qc * e_pos
    a_fwd = jnp.einsum('bhntd,bhnsd->bhnts', q_fwd, kc * e_neg)
    a_bwd = jnp.einsum('bhntd,bhnsd->bhnts', qc * e_neg, kc * e_pos)
    lower = jnp.tril(jnp.ones((CHUNK, CHUNK), dtype=bool))
    o_intra = jnp.einsum('bhnts,bhnsv->bhntv', jnp.where(lower, a_fwd, a_bwd), vc)
    k_to_end = kc * jnp.exp(cum[:, :, :, -1:, :] - cum)
    chunk_decay = jnp.exp(cum[:, :, :, -1, :])

    def step(state, inp):
        qs, ke, vv, dec = inp
        o = jnp.einsum('bhtk,bhkv->bhtv', qs, state)
        state = state * dec[..., None] + jnp.einsum('bhtk,bhtv->bhkv', ke, vv)
        return state, o

    s0 = jnp.zeros((B_, GLA_HEADS, GLA_DK_HEAD, GLA_DV_HEAD), jnp.float32)
    _, o_inter = lax.scan(step, s0, (jnp.moveaxis(q_fwd, 2, 0), jnp.moveaxis(k_to_end, 2, 0),
                                     jnp.moveaxis(vc, 2, 0), jnp.moveaxis(chunk_decay, 2, 0)))
    o = o_intra + jnp.moveaxis(o_inter, 0, 2)
    o = o * lax.rsqrt(jnp.mean(jnp.square(o), -1, keepdims=True) + RMS_EPS)
    o = o * g_norm.astype(jnp.float32)[None, :, None, None, :]
    o = o.transpose(0, 2, 3, 1, 4).reshape(B_, S_, GLA_DV).astype(u.dtype)
    return (o * jax.nn.silu(g)) @ w_out


def chunk_attention(u, w_in, b_in, rel_bias, w_out):
    B_, S_, _ = u.shape
    nC = S_ // CHUNK
    q, k, v = jnp.split(u @ w_in + b_in, 3, axis=-1)

    def heads(t):
        return t.reshape(B_, S_, ATT_HEADS, ATT_HEAD_DIM).transpose(0, 2, 1, 3)

    pad = LEFT_CHUNKS * CHUNK
    qc = (heads(q) * (ATT_HEAD_DIM ** -0.5)).reshape(B_, ATT_HEADS, nC, CHUNK, ATT_HEAD_DIM)
    kp = jnp.pad(heads(k), ((0, 0), (0, 0), (pad, 0), (0, 0)))
    vp = jnp.pad(heads(v), ((0, 0), (0, 0), (pad, 0), (0, 0)))
    key_valid = jnp.arange(S_ + pad) >= pad
    rel = jnp.clip(pad + jnp.arange(CHUNK)[:, None] - jnp.arange(BAND)[None, :], -MAX_REL, MAX_REL) + MAX_REL
    bias = rel_bias.astype(jnp.float32)[:, rel]

    def one_chunk(inp):
        qi, start = inp
        kb = lax.dynamic_slice_in_dim(kp, start, BAND, axis=2)
        vb = lax.dynamic_slice_in_dim(vp, start, BAND, axis=2)
        mb = lax.dynamic_slice_in_dim(key_valid, start, BAND)
        s = jnp.einsum('bhtd,bhjd->bhtj', qi, kb).astype(jnp.float32) + bias
        p = jax.nn.softmax(jnp.where(mb, s, NEG_INF), axis=-1).astype(vb.dtype)
        return jnp.einsum('bhtj,bhjd->bhtd', p, vb)

    o = lax.map(one_chunk, (jnp.moveaxis(qc, 2, 0), jnp.arange(nC) * CHUNK))
    o = o.transpose(1, 0, 3, 2, 4).reshape(B_, S_, D_MODEL)
    return o @ w_out


def squared_relu_mlp(u, w1, w2):
    return jnp.square(jax.nn.relu(u @ w1)) @ w2


def setup_inputs(seed: int = 0) -> dict:
    key = jax.random.key(seed)
    ks = jax.random.split(key, 16)
    nrm = lambda k, shape, s: jax.random.normal(k, shape, jnp.float32) * s
    D = D_MODEL
    return {
        "x": nrm(ks[0], (BATCH, SEQ, D), 1.0),
        "c": nrm(ks[1], (BATCH, D), 1.0),
        "w_ada": nrm(ks[2], (DEPTH, D, 6 * D), 0.1 * D ** -0.5),
        "b_ada": nrm(ks[3], (DEPTH, 6 * D), 0.02),
        "ln_g": 1.0 + nrm(ks[4], (DEPTH, 2, D), 0.02),
        "ln_b": nrm(ks[5], (DEPTH, 2, D), 0.02),
        "gla_w_in": nrm(ks[6], (N_GLA_LAYERS, D, GLA_IN_WIDTH), D ** -0.5),
        "gla_w_gk2": nrm(ks[7], (N_GLA_LAYERS, GLA_GATE_RANK, GLA_DK), GLA_GATE_RANK ** -0.5),
        "gla_b_gk": nrm(ks[8], (N_GLA_LAYERS, GLA_DK), 0.1),
        "gla_g_norm": 1.0 + nrm(ks[9], (N_GLA_LAYERS, GLA_HEADS, GLA_DV_HEAD), 0.02),
        "gla_w_out": nrm(ks[10], (N_GLA_LAYERS, GLA_DV, D), DEEPNORM_BETA * GLA_DV ** -0.5),
        "att_w_in": nrm(ks[11], (N_ATT_LAYERS, D, 3 * D), D ** -0.5),
        "att_b_in": nrm(ks[12], (N_ATT_LAYERS, 3 * D), 0.02),
        "att_rel_bias": nrm(ks[13], (N_ATT_LAYERS, ATT_HEADS, N_REL), 0.2),
        "att_w_out": nrm(ks[14], (N_ATT_LAYERS, D, D), DEEPNORM_BETA * D ** -0.5),
        "ff_w1": nrm(jax.random.fold_in(ks[15], 0), (DEPTH, D, D_FF), D ** -0.5),
        "ff_w2": nrm(jax.random.fold_in(ks[15], 1), (DEPTH, D_FF, D), DEEPNORM_BETA * D_FF ** -0.5),
    }


def reference(x, c, w_ada, b_ada, ln_g, ln_b, gla_w_in, gla_w_gk2, gla_b_gk, gla_g_norm, gla_w_out,
              att_w_in, att_b_in, att_rel_bias, att_w_out, ff_w1, ff_w2):
    c_act = jax.nn.silu(c)
    for i in range(DEPTH):
        mods = jnp.split(c_act @ w_ada[i] + b_ada[i], 6, axis=-1)
        sh1, sc1, g1, sh2, sc2, g2 = [m[:, None, :] for m in mods]
        u = x * (1.0 + sc1) + sh1
        j = i // N_MIXERS
        if i % N_MIXERS == 0:
            y = gla_mixer(u, gla_w_in[j], gla_w_gk2[j], gla_b_gk[j], gla_g_norm[j], gla_w_out[j])
        else:
            y = chunk_attention(u, att_w_in[j], att_b_in[j], att_rel_bias[j], att_w_out[j])
        x = layer_norm(DEEPNORM_ALPHA * x + (1.0 + g1) * y, ln_g[i, 0], ln_b[i, 0])
        u = x * (1.0 + sc2) + sh2
        y = squared_relu_mlp(u, ff_w1[i], ff_w2[i])
        x = layer_norm(DEEPNORM_ALPHA * x + (1.0 + g2) * y, ln_g[i, 1], ln_b[i, 1])
    return x
```

```cpp
#include <hip/hip_runtime.h>
#include <hip/hip_cooperative_groups.h>
#include <cstdio>
#include <cstdint>
namespace pg8 {
#define PG8_LAS __attribute__((address_space(3)))
typedef unsigned short bf16_t;
typedef short bf16x8 __attribute__((ext_vector_type(8)));
typedef float f32x4 __attribute__((ext_vector_type(4)));
typedef unsigned u32x4 __attribute__((ext_vector_type(4)));
constexpr int BM = 256, BK = 64, HALF = 128, HTB = HALF * BK * 2  , STAGE_BYTES = 8 * HTB, NXCD = 8, WGM = 8;

__host__ __device__ __forceinline__ int lds_byte(int r, int c) { const int st = (r >> 4) * 2 + (c >> 5), rr = r & 15, cc = c & 31, ob = rr * 64 + cc * 2; return st * 1024 + (ob ^ (((ob >> 9) & 1) << 5)); }
__host__ __device__ __forceinline__ void stage_rc(int b, int& R, int& C) { const int st = b / 1024, sb = b % 1024, swz = sb ^ (((sb >> 9) & 1) << 5); R = (st >> 1) * 16 + swz / 64; C = (st & 1) * 32 + (swz % 64) / 2; }
__host__ __device__ __forceinline__ int perm32(int rho) { const int n = rho >> 4, i = rho & 15; return 8 * (i >> 2) + 4 * n + (i & 3); }

struct Unit { int pm, pn; };
struct Gemm { const bf16_t* A; const bf16_t* Bt; int M, N, K; };

struct StaticOrder {
    int nM, nN, nwg, G, c;
    __host__ __device__ void init(int M, int N, int G_, int c_) { nM = M / BM; nN = N / BM; nwg = nM * nN; G = G_; c = c_; }
    __host__ __device__ bool next(int i, Unit& u) const {
        const long L = (long)i * G + c; if (L >= nwg) return false;
        int wgid = (int)L; { const int q = nwg / NXCD, r = nwg % NXCD, xcd = wgid % NXCD, off = wgid / NXCD; wgid = (xcd < r ? xcd * (q + 1) : r * (q + 1) + (xcd - r) * q) + off; }
        const int nig = WGM * nN, gid = wgid / nig, fm = gid * WGM, gsz = (nM - fm) < WGM ? (nM - fm) : WGM;
        u.pm = fm + ((wgid % nig) % gsz); u.pn = (wgid % nig) / gsz; return true;
    }
    __device__ __forceinline__ void a_ready(const Unit&) const {}
    __device__ __forceinline__ void done(const Unit&) const {}
};

__device__ __forceinline__ unsigned cvt_pk_bf16(float lo, float hi) { unsigned r; asm volatile("v_cvt_pk_bf16_f32 %0, %1, %2" : "=v"(r) : "v"(lo), "v"(hi)); return r; }
typedef float f32x2 __attribute__((ext_vector_type(2)));
__device__ __forceinline__ f32x2 gelu_pk(f32x2 v) {
    const f32x2 av = __builtin_elementwise_abs(v), d = av * 0.2316418882f + 1.0f;
    f32x2 t; t.x = __builtin_amdgcn_rcpf(d.x); t.y = __builtin_amdgcn_rcpf(d.y);
    f32x2 q = t * 0.5307027145f + (-0.7265760135f); q = q * t + 0.7107068705f; q = q * t + (-0.142248368f); q = q * t + 0.127414796f; q = q * t;
    const f32x2 s = (v * v) * (-0.72134752044f);
    f32x2 e; e.x = __builtin_amdgcn_exp2f(s.x); e.y = __builtin_amdgcn_exp2f(s.y);
    const f32x2 m = v * (q * e), r = v - m;
    f32x2 o; o.x = v.x < 0.f ? m.x : r.x; o.y = v.y < 0.f ? m.y : r.y; return o;
}

template <int ACT  > struct EpiBf16 {
    static constexpr bool PERM = true, AFTER_DRAIN = false; static_assert(ACT == 0 || ACT == 1 || ACT == 2, "EpiBf16: ACT");
    bf16_t* O; int ldc; const float* bias; int split_cols; size_t split_stride; float scale0;
    __device__ __forceinline__ void operator()(const f32x4 (&acc)[2][2][4][2], const Unit& u, int wr, int wc, int fr, int fq) const {
        const int row0 = u.pm * BM + wr * 64 + fr; int colt = u.pn * BM; bf16_t* base = O;
        float sc = 1.f; if (split_cols) { const int t = colt / split_cols; base += (size_t)t * split_stride; colt -= t * split_cols; if (t == 0) sc = scale0; }
        const int col0 = colt + wc * 32 + 8 * fq, bcol0 = u.pn * BM + wc * 32 + 8 * fq;
        f32x4 bv[2][2];
#pragma unroll
        for (int bj = 0; bj < 2; ++bj)
#pragma unroll
            for (int n = 0; n < 2; ++n) bv[bj][n] = bias ? *(const f32x4*)(bias + bcol0 + bj * HALF + 4 * n) : (f32x4){0.f, 0.f, 0.f, 0.f};
#pragma unroll
        for (int ai = 0; ai < 2; ++ai)
#pragma unroll
            for (int m = 0; m < 4; ++m) { bf16_t* rowp = base + (size_t)(row0 + ai * HALF + m * 16) * ldc + col0;
#pragma unroll
                for (int bj = 0; bj < 2; ++bj) { f32x4 v0 = acc[ai][bj][m][0] + bv[bj][0], v1 = acc[ai][bj][m][1] + bv[bj][1];
                    if (ACT == 1) { f32x2 a = gelu_pk((f32x2){v0[0], v0[1]}), b = gelu_pk((f32x2){v0[2], v0[3]}), c = gelu_pk((f32x2){v1[0], v1[1]}), d = gelu_pk((f32x2){v1[2], v1[3]});
                        v0 = (f32x4){a.x, a.y, b.x, b.y}; v1 = (f32x4){c.x, c.y, d.x, d.y}; }
                    if (ACT == 2) { _Pragma("unroll") for (int e_ = 0; e_ < 4; ++e_) { const float a_ = fmaxf(v0[e_], 0.f), b_ = fmaxf(v1[e_], 0.f); v0[e_] = a_ * a_; v1[e_] = b_ * b_; } }
                    v0 = v0 * sc; v1 = v1 * sc; u32x4 w; w.x = cvt_pk_bf16(v0[0], v0[1]); w.y = cvt_pk_bf16(v0[2], v0[3]); w.z = cvt_pk_bf16(v1[0], v1[1]); w.w = cvt_pk_bf16(v1[2], v1[3]);
                    *(u32x4*)(rowp + bj * HALF) = w; } }
    }
};

struct EpiF32 {
    static constexpr bool PERM = false, AFTER_DRAIN = false;
    float* O; int ldc;
    __device__ __forceinline__ void operator()(const f32x4 (&acc)[2][2][4][2], const Unit& u, int wr, int wc, int fr, int fq) const {
        const int col0 = u.pn * BM + wc * 32 + 4 * fq;
#pragma unroll
        for (int ai = 0; ai < 2; ++ai)
#pragma unroll
            for (int m = 0; m < 4; ++m) { float* rowp = O + (size_t)(u.pm * BM + ai * HALF + wr * 64 + m * 16 + fr) * ldc + col0;
#pragma unroll
                for (int bj = 0; bj < 2; ++bj)
#pragma unroll
                    for (int n = 0; n < 2; ++n) *(f32x4*)(rowp + bj * HALF + n * 16) = acc[ai][bj][m][n]; }
    }
};
template <class Epi, class Sched, bool ALIGN_EPI = false, bool SP2 = false>
__device__ __forceinline__ void gemm_phase(PG8_LAS unsigned char* lds, const Gemm g, const Sched& S, const Epi& E) {
    int tid_ = threadIdx.x; asm volatile("" : "+v"(tid_)); const int tid = tid_, wid = __builtin_amdgcn_readfirstlane(tid >> 6), lane = tid & 63, wr = wid >> 2, wc = wid & 3, fr = lane & 15, fq = lane >> 4;
    const int K = g.K, nt = K / BK;
    unsigned voffA[2], voffB[2];
#pragma unroll
    for (int i = 0; i < 2; ++i) { int R, C; stage_rc(tid * 16 + i * 8192, R, C); const int Rb = Epi::PERM ? ((R & ~31) + perm32(R & 31)) : R;
        voffA[i] = (unsigned)(R * K + C) * 2u; voffB[i] = (unsigned)(Rb * K + C) * 2u; }
    const size_t kstep = (size_t)(BK * 2);
    const size_t hstep = (size_t)HALF * K * 2;
    const size_t tstep = 2 * hstep;
    const unsigned ldsw = (unsigned)wid * 1024u;
    const int aoff = lds_byte(wr * 64 + fr, fq * 8), boff = lds_byte(wc * 32 + fr, fq * 8);
#define PG8_SA(b, h) (((b) * 2 + (h)) * HTB)
#define PG8_SB(b, h) ((4 + (b) * 2 + (h)) * HTB)
#define PG8_STAGE(bufoff, gbase, voff) do { _Pragma("unroll") for (int _i = 0; _i < 2; ++_i) \
        __builtin_amdgcn_global_load_lds((const unsigned*)((const char*)(gbase) + (voff)[_i]), (PG8_LAS unsigned*)(lds + (bufoff) + ldsw + _i * 8192), 16, 0, 0); } while (0)
#define PG8_LDA(dst, b, h) do { _Pragma("unroll") for (int m = 0; m < 4; ++m) _Pragma("unroll") for (int k = 0; k < 2; ++k) dst[m][k] = *(const PG8_LAS bf16x8*)(lds + PG8_SA(b, h) + aoff + m * 2048 + k * 1024); } while (0)
#define PG8_LDB(dst, b, h) do { _Pragma("unroll") for (int n = 0; n < 2; ++n) _Pragma("unroll") for (int k = 0; k < 2; ++k) dst[n][k] = *(const PG8_LAS bf16x8*)(lds + PG8_SB(b, h) + boff + n * 2048 + k * 1024); } while (0)
#define PG8_MMA(ai, bj, At, Bt) do { __builtin_amdgcn_s_setprio(1); _Pragma("unroll") for (int m = 0; m < 4; ++m) _Pragma("unroll") for (int n = 0; n < 2; ++n) _Pragma("unroll") for (int k = 0; k < 2; ++k) \
        acc[ai][bj][m][n] = __builtin_amdgcn_mfma_f32_16x16x32_bf16(Bt[n][k], At[m][k], acc[ai][bj][m][n], 0, 0, 0); __builtin_amdgcn_s_setprio(0); } while (0)
#define PG8_WAIT_V(n) asm volatile("s_waitcnt vmcnt(" #n ")" ::: "memory")
#define PG8_WAIT_L(n) asm volatile("s_waitcnt lgkmcnt(" #n ")" ::: "memory")
#define PG8_BAR __builtin_amdgcn_s_barrier()
#define PG8_SCHED __builtin_amdgcn_sched_barrier(0)
    Unit cur, nxt; int ui = 0;
    if (!S.next(0, cur)) return;
    f32x4 acc[2][2][4][2];
#pragma unroll
    for (int a = 0; a < 2; ++a)
#pragma unroll
        for (int b = 0; b < 2; ++b)
#pragma unroll
            for (int m = 0; m < 4; ++m)
#pragma unroll
                for (int n = 0; n < 2; ++n) acc[a][b][m][n] = (f32x4){0.f, 0.f, 0.f, 0.f};
    bf16x8 At[4][2], B0[2][2], B1[2][2];
    const char* cA = (const char*)g.A + (size_t)cur.pm * tstep; const char* cB = (const char*)g.Bt + (size_t)cur.pn * tstep;
    S.a_ready(cur);
    if constexpr (SP2) {
        PG8_STAGE(PG8_SB(0, 0), cB, voffB); PG8_STAGE(PG8_SB(0, 1), cB + hstep, voffB); PG8_STAGE(PG8_SA(0, 0), cA, voffA); PG8_STAGE(PG8_SA(0, 1), cA + hstep, voffA);
        if (wr == 1) PG8_BAR;
        PG8_WAIT_V(2); PG8_BAR;
        PG8_STAGE(PG8_SB(1, 0), cB + kstep, voffB); PG8_STAGE(PG8_SA(1, 0), cA + kstep, voffA); PG8_STAGE(PG8_SB(1, 1), cB + hstep + kstep, voffB);
        PG8_WAIT_V(6); PG8_BAR;
    } else {
        PG8_STAGE(PG8_SB(0, 0), cB, voffB); PG8_STAGE(PG8_SA(0, 0), cA, voffA); PG8_STAGE(PG8_SB(0, 1), cB + hstep, voffB); PG8_STAGE(PG8_SA(0, 1), cA + hstep, voffA);
        if (wr == 1) PG8_BAR;
        PG8_WAIT_V(4); PG8_BAR;
        PG8_STAGE(PG8_SB(1, 0), cB + kstep, voffB); PG8_STAGE(PG8_SA(1, 0), cA + kstep, voffA); PG8_STAGE(PG8_SB(1, 1), cB + hstep + kstep, voffB);
        PG8_WAIT_V(6); PG8_BAR;
    }
    for (;;) {
        const bool has_next = S.next(ui + 1, nxt);
        const char* nA = has_next ? (const char*)g.A + (size_t)nxt.pm * tstep : cA; const char* nB = has_next ? (const char*)g.Bt + (size_t)nxt.pn * tstep : cB;
        for (int t = 0; t < nt; t += 2) {
            const bool last = (t == nt - 2);
            const char* a1 = cA + (size_t)(t + 1) * kstep;
            const char* a2 = last ? nA : cA + (size_t)(t + 2) * kstep; const char* b2 = last ? nB : cB + (size_t)(t + 2) * kstep;
            const char* a3 = a2 + kstep; const char* b3 = b2 + kstep;
            if (last && has_next) S.a_ready(nxt);
            if constexpr (SP2) {
            PG8_LDB(B0, 0, 0); PG8_LDB(B1, 0, 1); PG8_SCHED; PG8_LDA(At, 0, 0); PG8_STAGE(PG8_SA(1, 1), a1 + hstep, voffA);
            PG8_WAIT_V(8); PG8_WAIT_L(0); PG8_BAR; PG8_MMA(0, 0, At, B0); PG8_MMA(0, 1, At, B1); PG8_BAR; PG8_SCHED;
            PG8_LDA(At, 0, 1); PG8_STAGE(PG8_SB(0, 0), b2, voffB); PG8_STAGE(PG8_SB(0, 1), b2 + hstep, voffB); PG8_STAGE(PG8_SA(0, 0), a2, voffA);
            PG8_WAIT_V(8); PG8_WAIT_L(0); PG8_BAR; PG8_MMA(1, 0, At, B0); PG8_MMA(1, 1, At, B1); PG8_BAR; PG8_SCHED;
            PG8_LDB(B0, 1, 0); PG8_LDB(B1, 1, 1); PG8_SCHED; PG8_LDA(At, 1, 0); PG8_STAGE(PG8_SA(0, 1), a2 + hstep, voffA);
            PG8_WAIT_V(8); PG8_WAIT_L(0); PG8_BAR; PG8_MMA(0, 0, At, B0); PG8_MMA(0, 1, At, B1); PG8_BAR; PG8_SCHED;
            PG8_LDA(At, 1, 1); PG8_STAGE(PG8_SB(1, 0), b3, voffB); PG8_STAGE(PG8_SB(1, 1), b3 + hstep, voffB); PG8_STAGE(PG8_SA(1, 0), a3, voffA);
            PG8_WAIT_V(8); PG8_WAIT_L(0); PG8_BAR; PG8_MMA(1, 0, At, B0); PG8_MMA(1, 1, At, B1); PG8_BAR; PG8_SCHED;
            } else {
            PG8_LDB(B0, 0, 0); PG8_SCHED; PG8_LDA(At, 0, 0); PG8_STAGE(PG8_SA(1, 1), a1 + hstep, voffA);
            PG8_WAIT_L(8); PG8_BAR; PG8_WAIT_L(0); PG8_MMA(0, 0, At, B0); PG8_BAR; PG8_SCHED;
            PG8_LDB(B1, 0, 1); PG8_STAGE(PG8_SB(0, 0), b2, voffB);
            PG8_BAR; PG8_WAIT_L(0); PG8_MMA(0, 1, At, B1); PG8_BAR;
            PG8_LDA(At, 0, 1); PG8_STAGE(PG8_SA(0, 0), a2, voffA);
            PG8_BAR; PG8_WAIT_L(0); PG8_MMA(1, 0, At, B0); PG8_BAR; PG8_SCHED;
            PG8_STAGE(PG8_SB(0, 1), b2 + hstep, voffB);
            PG8_WAIT_V(6); PG8_BAR; PG8_MMA(1, 1, At, B1); PG8_BAR;
            PG8_LDB(B0, 1, 0); PG8_SCHED; PG8_LDA(At, 1, 0); PG8_STAGE(PG8_SA(0, 1), a2 + hstep, voffA);
            PG8_WAIT_L(8); PG8_BAR; PG8_WAIT_L(0); PG8_MMA(0, 0, At, B0); PG8_BAR; PG8_SCHED;
            PG8_LDB(B1, 1, 1); PG8_STAGE(PG8_SB(1, 0), b3, voffB);
            PG8_BAR; PG8_WAIT_L(0); PG8_MMA(0, 1, At, B1); PG8_BAR;
            PG8_LDA(At, 1, 1); PG8_STAGE(PG8_SA(1, 0), a3, voffA);
            PG8_BAR; PG8_WAIT_L(0); PG8_MMA(1, 0, At, B0); PG8_BAR; PG8_SCHED;
            PG8_STAGE(PG8_SB(1, 1), b3 + hstep, voffB);
            PG8_WAIT_V(6); PG8_BAR; PG8_MMA(1, 1, At, B1); PG8_BAR;
            }
        }
        if constexpr (ALIGN_EPI) { if (wr == 0) PG8_BAR; }
        if constexpr (!Epi::AFTER_DRAIN) { E(acc, cur, wr, wc, fr, fq); S.done(cur); }
        if (!has_next) break;
#pragma unroll
        for (int a = 0; a < 2; ++a)
#pragma unroll
            for (int b = 0; b < 2; ++b)
#pragma unroll
                for (int m = 0; m < 4; ++m)
#pragma unroll
                    for (int n = 0; n < 2; ++n) acc[a][b][m][n] = (f32x4){0.f, 0.f, 0.f, 0.f};
        cur = nxt; cA = nA; cB = nB; ++ui;
        if constexpr (ALIGN_EPI) { if (wr == 1) PG8_BAR; }
    }
    PG8_WAIT_V(0);
    if constexpr (!ALIGN_EPI) { if (wr == 0) PG8_BAR; }
    PG8_BAR;
    if constexpr (Epi::AFTER_DRAIN) { E.fused(acc, cur, wr, wc, fr, fq, lds, wid, lane); S.done(cur); }
#undef PG8_SA
#undef PG8_SB
#undef PG8_STAGE
#undef PG8_LDA
#undef PG8_LDB
#undef PG8_MMA
#undef PG8_WAIT_V
#undef PG8_WAIT_L
#undef PG8_BAR
#undef PG8_SCHED
}
}

namespace cg = cooperative_groups;
#define LAS __attribute__((address_space(3)))
#define DI __device__ __forceinline__
typedef unsigned short bf16;
typedef unsigned u32x4 __attribute__((ext_vector_type(4)));
typedef unsigned u32x2 __attribute__((ext_vector_type(2)));
typedef float f32x4 __attribute__((ext_vector_type(4)));
typedef float f32x16 __attribute__((ext_vector_type(16)));
typedef short bf16x8 __attribute__((ext_vector_type(8)));
typedef short s16x4 __attribute__((ext_vector_type(4)));
typedef float f32x2_t __attribute__((ext_vector_type(2)));
typedef __bf16 bf16x2_t __attribute__((ext_vector_type(2)));

constexpr int NWAVES = 8, NTHR = 512;
constexpr int BATCH = 2, SEQ = 8192, D = 1024, M = BATCH * SEQ, FF = 4096, DEPTH = 4;
constexpr int NCH = SEQ / 64;
constexpr int GH = 4, GDK = 128, GDV = 256, GKT = 512, GIN = 3088;
constexpr int AH = 16, NREL = 257;
constexpr float DN_ALPHA = 1.6817928305074290f;
constexpr float LN_EPS = 1e-5f, RMS_EPS = 1e-6f;
constexpr float LOG2E = 1.4426950408889634f;
constexpr float ATT_C2 = 0.125f * LOG2E;
constexpr float GLA_QS = 0.08838834764831845f;

constexpr size_t MiB = 1u << 20;
constexpr size_t WS_CTL = 0;
constexpr size_t WS_MODS = 1 * MiB;
constexpr size_t WS_WLR = 1 * MiB + 512 * 1024;
constexpr size_t WS_WT = 2 * MiB;
constexpr size_t WT_LAYER = 24 * MiB, WT_IN = 0, WT_OUT = 6 * MiB, WT_W1 = 8 * MiB, WT_W2 = 16 * MiB;
constexpr size_t WS_U = 98 * MiB;
constexpr size_t WS_BIG = 130 * MiB;
constexpr size_t WS_O = WS_BIG + 96 * MiB;
constexpr size_t WS_ST = 258 * MiB;
constexpr size_t WS_CUM = 322 * MiB;
constexpr size_t WS_DEC2 = 354 * MiB;
constexpr size_t WS_END = 355 * MiB;

constexpr int RING_BYTES = 131072, LDS_BYTES = 147456;

DI unsigned cvtpk(float lo, float hi) { f32x2_t v = {lo, hi}; bf16x2_t b = __builtin_convertvector(v, bf16x2_t); return __builtin_bit_cast(unsigned, b); }
DI float bf2f(unsigned short h) { return __uint_as_float((unsigned)h << 16); }
DI float bflo(unsigned w) { return __uint_as_float(w << 16); }
DI float bfhi(unsigned w) { return __uint_as_float(w & 0xffff0000u); }
DI int crow(int r, int hi) { return (r & 3) + 8 * (r >> 2) + 4 * hi; }
#define MFMA32(a, b, c) __builtin_amdgcn_mfma_f32_32x32x16_bf16((a), (b), (c), 0, 0, 0)
DI float wave_sum(float v) {
#pragma unroll
    for (int o = 1; o < 64; o <<= 1) v += __shfl_xor(v, o);
    return v;
}

struct Frame {
    LAS unsigned char* lds;
    int vcu, G;
    const float* in[17];
    float* out; unsigned char* ws;
};

DI void p0_transpose_item(const float* W, int ld, int Ncols, int K, bf16* WT, LAS float* scr, int item, int lane) {
    const int nblk = Ncols / 32, kb = item / nblk, nb = item % nblk, k0 = 64 * kb, n0 = 32 * nb;
#pragma unroll 8
    for (int i = 0; i < 32; ++i) { const int kk = 2 * i + (lane >> 5); scr[kk * 33 + (lane & 31)] = W[(size_t)(k0 + kk) * ld + n0 + (lane & 31)]; }
    asm volatile("s_waitcnt lgkmcnt(0)" ::: "memory");
    const int c = lane & 7;
#pragma unroll
    for (int j = 0; j < 4; ++j) { const int n = (lane >> 3) + 8 * j; const LAS float* s = scr + (8 * c) * 33 + n;
        u32x4 o; o.x = cvtpk(s[0 * 33], s[1 * 33]); o.y = cvtpk(s[2 * 33], s[3 * 33]); o.z = cvtpk(s[4 * 33], s[5 * 33]); o.w = cvtpk(s[6 * 33], s[7 * 33]);
        *(u32x4*)(WT + (size_t)(n0 + n) * K + k0 + 8 * c) = o; }
    asm volatile("s_waitcnt lgkmcnt(0)" ::: "memory");
}

DI void p0a_prologue(Frame& F) {
    int tid = threadIdx.x; asm volatile("" : "+v"(tid)); const int lane = tid & 63, wid = __builtin_amdgcn_readfirstlane(tid >> 6); (void)lane; (void)wid;
    const float* c_in = F.in[1]; const float* w_ada = F.in[2]; const float* b_ada = F.in[3];
    float* mods = (float*)(F.ws + WS_MODS);
    LAS float* cact = (LAS float*)(F.lds);
    LAS float* red = (LAS float*)(F.lds + 8192);
    for (int i = tid; i < 2048; i += NTHR) { const float v = c_in[i]; cact[i] = v / (1.f + __expf(-v)); }
    __syncthreads();
    for (int tm = blockIdx.x; tm < 384; tm += F.G) {
        const int layer = tm / 96, cb = tm % 96;
        const float* wp = w_ada + (size_t)layer * D * 6144 + (size_t)(128 * wid) * 6144 + 64 * cb + lane;
        float a0 = 0.f, a1 = 0.f;
#pragma unroll 16
        for (int k = 0; k < 128; ++k) { const float wv = wp[(size_t)k * 6144]; a0 += cact[128 * wid + k] * wv; a1 += cact[1024 + 128 * wid + k] * wv; }
        red[(wid * 2 + 0) * 64 + lane] = a0; red[(wid * 2 + 1) * 64 + lane] = a1;
        __syncthreads();
        if (tid < 128) { const int b = tid >> 6, col = tid & 63; float s = 0.f;
#pragma unroll
            for (int w = 0; w < 8; ++w) s += red[(w * 2 + b) * 64 + col];
            mods[(size_t)(layer * 2 + b) * 6144 + 64 * cb + col] = s + b_ada[layer * 6144 + 64 * cb + col]; }
        __syncthreads();
    }
    { bf16* wlr = (bf16*)(F.ws + WS_WLR); const int gt = blockIdx.x * NTHR + tid;
      if (gt < 32768) { const int j = gt >> 14, n = (gt >> 10) & 15, k = gt & 1023;
          const float v = F.in[6][(size_t)j * D * GIN + (size_t)k * GIN + 3072 + n]; wlr[gt] = (bf16)(cvtpk(v, 0.f) & 0xffffu); (void)n; } }
    LAS float* scr = (LAS float*)(F.lds + 16384 + wid * 12288);
    const int gw = F.vcu * NWAVES + wid, NGW = F.G * NWAVES;
    constexpr int I_IN = 16 * 96, I_OUT = 16 * 32, I_W1 = 16 * 128, I_W2 = 64 * 32, I_LAYER = I_IN + I_OUT + I_W1 + I_W2;
    for (int it = gw; it < DEPTH * I_LAYER; it += NGW) {
        const int layer = it / I_LAYER; int r = it % I_LAYER; const int j = layer >> 1; const bool gla = (layer & 1) == 0;
        unsigned char* wt = F.ws + WS_WT + (size_t)layer * WT_LAYER;
        if (r < I_IN) { if (gla) p0_transpose_item(F.in[6] + (size_t)j * D * GIN, GIN, 3072, D, (bf16*)(wt + WT_IN), scr, r, lane);
                        else p0_transpose_item(F.in[11] + (size_t)j * D * 3072, 3072, 3072, D, (bf16*)(wt + WT_IN), scr, r, lane); continue; }
        r -= I_IN;
        if (r < I_OUT) { p0_transpose_item((gla ? F.in[10] : F.in[14]) + (size_t)j * D * D, D, D, D, (bf16*)(wt + WT_OUT), scr, r, lane); continue; }
        r -= I_OUT;
        if (r < I_W1) { p0_transpose_item(F.in[15] + (size_t)layer * D * FF, FF, FF, D, (bf16*)(wt + WT_W1), scr, r, lane); continue; }
        r -= I_W1;
        p0_transpose_item(F.in[16] + (size_t)layer * FF * D, D, D, FF, (bf16*)(wt + WT_W2), scr, r, lane);
    }
}

DI void mod_rows(Frame& F, const float* x, bf16* U, const float* sh, const float* sc) {
    int tid = threadIdx.x; asm volatile("" : "+v"(tid)); const int lane = tid & 63, wid = __builtin_amdgcn_readfirstlane(tid >> 6); (void)lane; (void)wid;
    const int gw = F.vcu * NWAVES + wid, NGW = F.G * NWAVES;
    for (int m = gw; m < M; m += NGW) {
        const int b = m >> 13; const float* shb = sh + b * 6144; const float* scb = sc + b * 6144;
#pragma unroll
        for (int j = 0; j < 4; ++j) { const int col = 4 * lane + 256 * j;
            const f32x4 v = *(const f32x4*)(x + (size_t)m * D + col), s1 = *(const f32x4*)(scb + col), s0 = *(const f32x4*)(shb + col);
            const f32x4 u = v * (s1 + 1.0f) + s0; u32x2 w; w.x = cvtpk(u[0], u[1]); w.y = cvtpk(u[2], u[3]);
            *(u32x2*)(U + (size_t)m * D + col) = w; }
    }
}

DI void ln_phase(Frame& F, const float* xin, const float* Y, float* xout, bf16* U, const float* gate, const float* lng, const float* lnb, const float* sh, const float* sc) {
    int tid = threadIdx.x; asm volatile("" : "+v"(tid)); const int lane = tid & 63, wid = __builtin_amdgcn_readfirstlane(tid >> 6); (void)lane; (void)wid;
    const int gw = F.vcu * NWAVES + wid, NGW = F.G * NWAVES;
    for (int m = gw; m < M; m += NGW) {
        const int b = m >> 13; const float* gb = gate + b * 6144;
        f32x4 t[4]; float s = 0.f;
#pragma unroll
        for (int j = 0; j < 4; ++j) { const int col = 4 * lane + 256 * j;
            const f32x4 xv = *(const f32x4*)(xin + (size_t)m * D + col), yv = *(const f32x4*)(Y + (size_t)m * D + col), gv = *(const f32x4*)(gb + col);
            t[j] = xv * DN_ALPHA + (gv + 1.0f) * yv; s += (t[j][0] + t[j][1]) + (t[j][2] + t[j][3]); }
        const float mean = wave_sum(s) * (1.f / D); float s2 = 0.f;
#pragma unroll
        for (int j = 0; j < 4; ++j) { t[j] = t[j] - mean; s2 += (t[j][0] * t[j][0] + t[j][1] * t[j][1]) + (t[j][2] * t[j][2] + t[j][3] * t[j][3]); }
        const float rstd = 1.f / sqrtf(wave_sum(s2) * (1.f / D) + LN_EPS);
#pragma unroll
        for (int j = 0; j < 4; ++j) { const int col = 4 * lane + 256 * j;
            const f32x4 o = t[j] * rstd * *(const f32x4*)(lng + col) + *(const f32x4*)(lnb + col);
            *(f32x4*)(xout + (size_t)m * D + col) = o;
            if (U) { const f32x4 u = o * (*(const f32x4*)(sc + b * 6144 + col) + 1.0f) + *(const f32x4*)(sh + b * 6144 + col);
                u32x2 w; w.x = cvtpk(u[0], u[1]); w.y = cvtpk(u[2], u[3]); *(u32x2*)(U + (size_t)m * D + col) = w; } }
    }
}

constexpr int AKP = 72;
constexpr int ATT_OFF_K = 0, ATT_OFF_V = 2 * 64 * AKP * 2, ATT_OFF_B = 4 * 64 * AKP * 2;
DI void attn_phase(Frame& F, const bf16* Q, const bf16* K, const bf16* V, bf16* O, const float* relb) {
    int tid = threadIdx.x; asm volatile("" : "+v"(tid)); const int lane = tid & 63, wid = __builtin_amdgcn_readfirstlane(tid >> 6); (void)lane; (void)wid; const int r32 = lane & 31, hi = lane >> 5;
    LAS bf16* Kl = (LAS bf16*)(F.lds + ATT_OFF_K); LAS bf16* Vl = (LAS bf16*)(F.lds + ATT_OFF_V); LAS float* biasL = (LAS float*)(F.lds + ATT_OFF_B);
    const int srow = tid >> 3, sch = tid & 7;
    for (int u = F.vcu; u < 1024; u += F.G) {
        const int v8 = u & 255, it = u >> 8, bh = (v8 >> 5) * 4 + it, qb = ((v8 & 31) + 8 * it) & 31;
        const int b = bh >> 4, h = bh & 15; const size_t rowbase = (size_t)b * SEQ; const int q0 = qb * 256;
        if (tid < NREL) biasL[tid] = relb[h * NREL + tid] * LOG2E;
        const bf16* Qw = Q + (rowbase + q0 + wid * 32 + r32) * D + h * 64;
        bf16x8 qr[4];
#pragma unroll
        for (int d0 = 0; d0 < 4; ++d0) qr[d0] = *(const bf16x8*)(Qw + d0 * 16 + hi * 8);
        const int cw = 4 * qb + (wid >> 1), tq = (wid & 1) * 32 + r32;
        const int jt0 = (4 * qb - 8) > 0 ? (4 * qb - 8) : 0, jt1 = 4 * qb + 3;
        const bf16* Kg = K + (rowbase + srow) * D + h * 64 + sch * 8; const bf16* Vg = V + (rowbase + srow) * D + h * 64 + sch * 8;
        u32x4 kreg = *(const u32x4*)(Kg + (size_t)jt0 * 64 * D), vreg = *(const u32x4*)(Vg + (size_t)jt0 * 64 * D);
        {   LAS bf16* kd = Kl; LAS bf16* vd = Vl;
            *(LAS u32x4*)(kd + srow * AKP + sch * 8) = kreg;
#pragma unroll
            for (int e = 0; e < 4; ++e) { vd[(sch * 8 + 2 * e) * AKP + srow] = (bf16)(vreg[e] & 0xffffu); vd[(sch * 8 + 2 * e + 1) * AKP + srow] = (bf16)(vreg[e] >> 16); } }
        __syncthreads();
        f32x16 oT[2];
#pragma unroll
        for (int r = 0; r < 16; ++r) { oT[0][r] = 0.f; oT[1][r] = 0.f; }
        float mrun = -1e30f, lrun = 0.f;
        const float biasFar = biasL[256];
        for (int jt = jt0; jt <= jt1; ++jt) {
            const int cur = (jt - jt0) & 1;
            if (jt < jt1) { kreg = *(const u32x4*)(Kg + (size_t)(jt + 1) * 64 * D); vreg = *(const u32x4*)(Vg + (size_t)(jt + 1) * 64 * D); }
            const int dc = cw - jt;
            if (dc >= 0 && dc <= 8) {
                const LAS bf16* kc = Kl + cur * 64 * AKP; const LAS bf16* vc = Vl + cur * 64 * AKP;
                const float binit = (dc >= 3) ? biasFar : 0.f;
                f32x16 p0, p1;
#pragma unroll
                for (int r = 0; r < 16; ++r) { p0[r] = binit; p1[r] = binit; }
#pragma unroll
                for (int d0 = 0; d0 < 4; ++d0) {
                    const bf16x8 a0 = *(const LAS bf16x8*)(kc + r32 * AKP + d0 * 16 + hi * 8);
                    const bf16x8 a1 = *(const LAS bf16x8*)(kc + (32 + r32) * AKP + d0 * 16 + hi * 8);
                    p0 = MFMA32(a0, qr[d0], p0); p1 = MFMA32(a1, qr[d0], p1); }
                if (dc <= 2) {
#pragma unroll
                    for (int r = 0; r < 16; ++r) { const int d = 64 * dc + tq - crow(r, hi); const int i0 = (d < 128 ? d : 128) + 128, d1 = d - 32, i1 = (d1 < 128 ? d1 : 128) + 128;
                        p0[r] += biasL[i0]; p1[r] += biasL[i1]; }
                }
                float mt = fmaxf(p0[0], p1[0]);
#pragma unroll
                for (int r = 1; r < 16; ++r) mt = fmaxf(mt, fmaxf(p0[r], p1[r]));
                mt = fmaxf(mt, __shfl_xor(mt, 32));
                const float mn = fmaxf(mrun, mt), al = __builtin_amdgcn_exp2f(mrun - mn); mrun = mn;
                float ls = 0.f;
#pragma unroll
                for (int r = 0; r < 16; ++r) { p0[r] = __builtin_amdgcn_exp2f(p0[r] - mn); p1[r] = __builtin_amdgcn_exp2f(p1[r] - mn); ls += p0[r] + p1[r]; oT[0][r] *= al; oT[1][r] *= al; }
                lrun = lrun * al + ls;
                bf16x8 pw[2][2];
#pragma unroll
                for (int s = 0; s < 2; ++s) {
                    u32x4 w0, w1;
                    w0.x = cvtpk(p0[8 * s + 0], p0[8 * s + 1]); w0.y = cvtpk(p0[8 * s + 2], p0[8 * s + 3]); w0.z = cvtpk(p0[8 * s + 4], p0[8 * s + 5]); w0.w = cvtpk(p0[8 * s + 6], p0[8 * s + 7]);
                    w1.x = cvtpk(p1[8 * s + 0], p1[8 * s + 1]); w1.y = cvtpk(p1[8 * s + 2], p1[8 * s + 3]); w1.z = cvtpk(p1[8 * s + 4], p1[8 * s + 5]); w1.w = cvtpk(p1[8 * s + 6], p1[8 * s + 7]);
                    pw[0][s] = __builtin_bit_cast(bf16x8, w0); pw[1][s] = __builtin_bit_cast(bf16x8, w1); }
#pragma unroll
                for (int d0 = 0; d0 < 2; ++d0)
#pragma unroll
                    for (int hf = 0; hf < 2; ++hf)
#pragma unroll
                        for (int s = 0; s < 2; ++s) {
                            const LAS bf16* vp = vc + (32 * d0 + r32) * AKP + 32 * hf + 16 * s + 4 * hi;
                            const s16x4 lo = *(const LAS s16x4*)(vp), hh = *(const LAS s16x4*)(vp + 8);
                            const bf16x8 af = __builtin_shufflevector(lo, hh, 0, 1, 2, 3, 4, 5, 6, 7);
                            oT[d0] = MFMA32(af, pw[hf][s], oT[d0]); }
            }
            if (jt < jt1) { LAS bf16* kd = Kl + (cur ^ 1) * 64 * AKP; LAS bf16* vd = Vl + (cur ^ 1) * 64 * AKP;
                *(LAS u32x4*)(kd + srow * AKP + sch * 8) = kreg;
#pragma unroll
                for (int e = 0; e < 4; ++e) { vd[(sch * 8 + 2 * e) * AKP + srow] = (bf16)(vreg[e] & 0xffffu); vd[(sch * 8 + 2 * e + 1) * AKP + srow] = (bf16)(vreg[e] >> 16); } }
            __syncthreads();
        }
        const float lt = lrun + __shfl_xor(lrun, 32), inv = 1.f / lt;
        bf16* Ow = O + (rowbase + q0 + wid * 32 + r32) * D + h * 64;
#pragma unroll
        for (int d0 = 0; d0 < 2; ++d0)
#pragma unroll
            for (int g = 0; g < 4; ++g) { u32x2 w; w.x = cvtpk(oT[d0][4 * g] * inv, oT[d0][4 * g + 1] * inv); w.y = cvtpk(oT[d0][4 * g + 2] * inv, oT[d0][4 * g + 3] * inv);
                *(u32x2*)(Ow + 32 * d0 + 8 * g + 4 * hi) = w; }
    }
}

DI float log_sigmoid(float z) { return fminf(z, 0.f) - __logf(1.f + __expf(-fabsf(z))); }
constexpr int VTP = 72, QKP = 136;
DI void stage_vt(Frame& F, int tid, const bf16* QKVG, size_t r0, int h, LAS bf16* VT) {
#pragma unroll
    for (int i = 0; i < 4; ++i) { const int idx = tid + NTHR * i, s = idx >> 5, ch = idx & 31;
        const u32x4 v = *(const u32x4*)(QKVG + (r0 + s) * 3072 + 1024 + h * 256 + ch * 8);
#pragma unroll
        for (int e = 0; e < 4; ++e) { VT[(ch * 8 + 2 * e) * VTP + s] = (bf16)(v[e] & 0xffffu); VT[(ch * 8 + 2 * e + 1) * VTP + s] = (bf16)(v[e] >> 16); } }
}
constexpr int GA_OFF_PART = 0, GA_OFF_GK = 16384, GA_OFF_KET = 20480, GA_OFF_VT = 94208;
DI void gla_pass_a(Frame& F, const bf16* U, const bf16* QKVG, const bf16* wlr, const float* w_gk2, const float* b_gk, float* CUM, float* DEC, bf16* ST) {
    int tid = threadIdx.x; asm volatile("" : "+v"(tid)); const int lane = tid & 63, wid = __builtin_amdgcn_readfirstlane(tid >> 6); (void)lane; (void)wid; const int r32 = lane & 31, hi = lane >> 5;
    LAS float* part = (LAS float*)(F.lds + GA_OFF_PART); LAS float* GK = (LAS float*)(F.lds + GA_OFF_GK);
    LAS bf16* KET = (LAS bf16*)(F.lds + GA_OFF_KET); LAS bf16* VT = (LAS bf16*)(F.lds + GA_OFF_VT);
    for (int u = F.vcu; u < BATCH * NCH; u += F.G) {
        const int b = u >> 7, n = u & 127; const size_t r0 = (size_t)b * SEQ + 64 * n;
        { const int rb = wid & 1, kq = wid >> 1;
          const bf16* Ur = U + (r0 + 32 * rb + r32) * D + kq * 256 + hi * 8; const bf16* Wl = wlr + (r32 & 15) * D + kq * 256 + hi * 8;
          f32x16 acc;
#pragma unroll
          for (int r = 0; r < 16; ++r) acc[r] = 0.f;
#pragma unroll 4
          for (int ks = 0; ks < 16; ++ks) { const bf16x8 a = *(const bf16x8*)(Ur + 16 * ks); bf16x8 bq = *(const bf16x8*)(Wl + 16 * ks);
              if (r32 >= 16) bq = (bf16x8){0, 0, 0, 0, 0, 0, 0, 0};
              acc = MFMA32(a, bq, acc); }
          if (r32 < 16) {
#pragma unroll
              for (int r = 0; r < 16; ++r) part[(wid * 32 + crow(r, hi)) * 16 + r32] = acc[r]; }
        }
        __syncthreads();
#pragma unroll
        for (int i = 0; i < 2; ++i) { const int o = tid + NTHR * i, row = o >> 4, j = o & 15, rb = row >> 5; float s = 0.f;
#pragma unroll
            for (int kq = 0; kq < 4; ++kq) s += part[((kq * 2 + rb) * 32 + (row & 31)) * 16 + j];
            GK[row * 16 + j] = s; }
        __syncthreads();
        { const int c = tid; float w2[16];
#pragma unroll
          for (int j = 0; j < 16; ++j) w2[j] = w_gk2[j * GKT + c];
          const float bg = b_gk[c]; float cum = 0.f; float cumv[64];
#pragma unroll
          for (int t = 0; t < 64; ++t) {
              const f32x4 g0 = *(const LAS f32x4*)(GK + t * 16), g1 = *(const LAS f32x4*)(GK + t * 16 + 4), g2 = *(const LAS f32x4*)(GK + t * 16 + 8), g3 = *(const LAS f32x4*)(GK + t * 16 + 12);
              float z = bg;
              z += g0[0] * w2[0] + g0[1] * w2[1] + g0[2] * w2[2] + g0[3] * w2[3];
              z += g1[0] * w2[4] + g1[1] * w2[5] + g1[2] * w2[6] + g1[3] * w2[7];
              z += g2[0] * w2[8] + g2[1] * w2[9] + g2[2] * w2[10] + g2[3] * w2[11];
              z += g3[0] * w2[12] + g3[1] * w2[13] + g3[2] * w2[14] + g3[3] * w2[15];
              cum += log_sigmoid(z) * (1.f / 16.f); cumv[t] = cum; CUM[(r0 + t) * GKT + c] = cum; }
          DEC[(size_t)u * GKT + c] = __expf(cum);
          const bf16* kp = QKVG + r0 * 3072 + 512 + c;
#pragma unroll
          for (int t8 = 0; t8 < 8; ++t8) { float ke[8];
#pragma unroll
              for (int e = 0; e < 8; ++e) { const int t = 8 * t8 + e; ke[e] = bf2f(kp[(size_t)t * 3072]) * __expf(cum - cumv[t]); }
              u32x4 w; w.x = cvtpk(ke[0], ke[1]); w.y = cvtpk(ke[2], ke[3]); w.z = cvtpk(ke[4], ke[5]); w.w = cvtpk(ke[6], ke[7]);
              *(LAS u32x4*)(KET + c * VTP + 8 * t8) = w; }
        }
        for (int h = 0; h < GH; ++h) {
            stage_vt(F, tid, QKVG, r0, h, VT);
            __syncthreads();
            f32x16 acc[4];
#pragma unroll
            for (int nb = 0; nb < 4; ++nb)
#pragma unroll
                for (int r = 0; r < 16; ++r) acc[nb][r] = 0.f;
#pragma unroll
            for (int ks = 0; ks < 4; ++ks) { const bf16x8 a = *(const LAS bf16x8*)(VT + (32 * wid + r32) * VTP + 16 * ks + 8 * hi);
#pragma unroll
                for (int nb = 0; nb < 4; ++nb) { const bf16x8 bq = *(const LAS bf16x8*)(KET + (h * 128 + 32 * nb + r32) * VTP + 16 * ks + 8 * hi); acc[nb] = MFMA32(a, bq, acc[nb]); } }
            bf16* sp = ST + ((size_t)((b * GH + h) * NCH + n) * GDV + 32 * wid) * GDK;
#pragma unroll
            for (int nb = 0; nb < 4; ++nb)
#pragma unroll
                for (int r = 0; r < 16; ++r) sp[(size_t)crow(r, hi) * GDK + 32 * nb + r32] = (bf16)(cvtpk(acc[nb][r], 0.f) & 0xffffu);
            __syncthreads();
        }
    }
}
DI void gla_scan(Frame& F, const float* DEC, bf16* ST) {
    int tid = threadIdx.x; asm volatile("" : "+v"(tid)); const int lane = tid & 63, wid = __builtin_amdgcn_readfirstlane(tid >> 6); (void)lane; (void)wid;
    const int gt = F.vcu * NTHR + tid, NGT = F.G * NTHR;
    for (int p = gt; p < 8 * 16384; p += NGT) {
        const int bh = p >> 14, e = (p & 16383) * 2, dk = e & 127, b = bh >> 2, h = bh & 3;
        unsigned* base = (unsigned*)(ST + (size_t)bh * NCH * 32768 + e);
        const float* dbase = DEC + (size_t)b * NCH * GKT + h * 128 + dk;
        float s0 = 0.f, s1 = 0.f;
        for (int n0 = 0; n0 < NCH; n0 += 8) {
            unsigned kv[8]; f32x2_t dd[8];
#pragma unroll
            for (int i = 0; i < 8; ++i) { kv[i] = base[(size_t)(n0 + i) * 16384]; dd[i] = *(const f32x2_t*)(dbase + (size_t)(n0 + i) * GKT); }
#pragma unroll
            for (int i = 0; i < 8; ++i) { base[(size_t)(n0 + i) * 16384] = cvtpk(s0, s1); s0 = dd[i][0] * s0 + bflo(kv[i]); s1 = dd[i][1] * s1 + bfhi(kv[i]); }
        }
    }
}
constexpr int GC_OFF_QF = 0, GC_OFF_QB = 17408, GC_OFF_KN = 34816, GC_OFF_KP = 52224, GC_OFF_VT = 69632, GC_OFF_P = 106496, GC_OFF_SS = 115712, GC_OFF_RS = 116736;
DI void gla_pass_c(Frame& F, const bf16* QKVG, const float* CUM, const bf16* ST, const float* g_norm, bf16* O) {
    int tid = threadIdx.x; asm volatile("" : "+v"(tid)); const int lane = tid & 63, wid = __builtin_amdgcn_readfirstlane(tid >> 6); (void)lane; (void)wid; const int r32 = lane & 31, hi = lane >> 5;
    LAS bf16* QF = (LAS bf16*)(F.lds + GC_OFF_QF); LAS bf16* QB = (LAS bf16*)(F.lds + GC_OFF_QB); LAS bf16* KN = (LAS bf16*)(F.lds + GC_OFF_KN); LAS bf16* KP = (LAS bf16*)(F.lds + GC_OFF_KP);
    LAS bf16* VT = (LAS bf16*)(F.lds + GC_OFF_VT); LAS bf16* P = (LAS bf16*)(F.lds + GC_OFF_P); LAS float* SS = (LAS float*)(F.lds + GC_OFF_SS); LAS float* RS = (LAS float*)(F.lds + GC_OFF_RS);
    for (int u = F.vcu; u < 8 * NCH; u += F.G) {
        const int bh = u >> 7, n = u & 127, b = bh >> 2, h = bh & 3; const size_t r0 = (size_t)b * SEQ + 64 * n;
        const int tb = wid & 1, dq = wid >> 1;
        bf16x8 Sfr[2][8];
        { const bf16* sp = ST + ((size_t)(bh * NCH + n) * GDV + 64 * dq + r32) * GDK + 8 * hi;
#pragma unroll
          for (int dvb = 0; dvb < 2; ++dvb)
#pragma unroll
              for (int ks = 0; ks < 8; ++ks) Sfr[dvb][ks] = *(const bf16x8*)(sp + (size_t)(32 * dvb) * GDK + 16 * ks); }
#pragma unroll
        for (int i = 0; i < 2; ++i) { const int idx = tid + NTHR * i, t = idx >> 4, c8 = idx & 15;
            const u32x4 q8 = *(const u32x4*)(QKVG + (r0 + t) * 3072 + h * 128 + c8 * 8), k8 = *(const u32x4*)(QKVG + (r0 + t) * 3072 + 512 + h * 128 + c8 * 8);
            const f32x4 c0 = *(const f32x4*)(CUM + (r0 + t) * GKT + h * 128 + c8 * 8), c1 = *(const f32x4*)(CUM + (r0 + t) * GKT + h * 128 + c8 * 8 + 4);
            float qf[8], qb[8], kn[8], kp[8];
#pragma unroll
            for (int e = 0; e < 8; ++e) { const float cm = e < 4 ? c0[e & 3] : c1[e & 3]; const float ep = __expf(cm), en = __expf(-cm);
                const unsigned qw = q8[e >> 1], kw = k8[e >> 1]; const float qv = ((e & 1) ? bfhi(qw) : bflo(qw)) * GLA_QS, kv = (e & 1) ? bfhi(kw) : bflo(kw);
                qf[e] = qv * ep; qb[e] = qv * en; kn[e] = kv * en; kp[e] = kv * ep; }
            u32x4 w;
            w.x = cvtpk(qf[0], qf[1]); w.y = cvtpk(qf[2], qf[3]); w.z = cvtpk(qf[4], qf[5]); w.w = cvtpk(qf[6], qf[7]); *(LAS u32x4*)(QF + t * QKP + c8 * 8) = w;
            w.x = cvtpk(qb[0], qb[1]); w.y = cvtpk(qb[2], qb[3]); w.z = cvtpk(qb[4], qb[5]); w.w = cvtpk(qb[6], qb[7]); *(LAS u32x4*)(QB + t * QKP + c8 * 8) = w;
            w.x = cvtpk(kn[0], kn[1]); w.y = cvtpk(kn[2], kn[3]); w.z = cvtpk(kn[4], kn[5]); w.w = cvtpk(kn[6], kn[7]); *(LAS u32x4*)(KN + t * QKP + c8 * 8) = w;
            w.x = cvtpk(kp[0], kp[1]); w.y = cvtpk(kp[2], kp[3]); w.z = cvtpk(kp[4], kp[5]); w.w = cvtpk(kp[6], kp[7]); *(LAS u32x4*)(KP + t * QKP + c8 * 8) = w; }
        stage_vt(F, tid, QKVG, r0, h, VT);
        __syncthreads();
        { const int sb = wid & 1, tb2 = (wid >> 1) & 1, var = wid >> 2;
          const LAS bf16* Aop = (var ? KP : KN) + (32 * sb + r32) * QKP + 8 * hi; const LAS bf16* Bop = (var ? QB : QF) + (32 * tb2 + r32) * QKP + 8 * hi;
          f32x16 acc;
#pragma unroll
          for (int r = 0; r < 16; ++r) acc[r] = 0.f;
#pragma unroll
          for (int ks = 0; ks < 8; ++ks) { const bf16x8 a = *(const LAS bf16x8*)(Aop + 16 * ks), bq = *(const LAS bf16x8*)(Bop + 16 * ks); acc = MFMA32(a, bq, acc); }
          const int t = 32 * tb2 + r32;
#pragma unroll
          for (int r = 0; r < 16; ++r) { const int s = 32 * sb + crow(r, hi); const bool take = var ? (s > t) : (s <= t);
              if (take) P[t * VTP + s] = (bf16)(cvtpk(acc[r], 0.f) & 0xffffu); }
        }
        __syncthreads();
        f32x16 acc[2];
#pragma unroll
        for (int r = 0; r < 16; ++r) { acc[0][r] = 0.f; acc[1][r] = 0.f; }
#pragma unroll
        for (int ks = 0; ks < 8; ++ks) { const bf16x8 a = *(const LAS bf16x8*)(QF + (32 * tb + r32) * QKP + 16 * ks + 8 * hi);
            acc[0] = MFMA32(a, Sfr[0][ks], acc[0]); acc[1] = MFMA32(a, Sfr[1][ks], acc[1]); }
#pragma unroll
        for (int ss = 0; ss < 4; ++ss) { const bf16x8 a = *(const LAS bf16x8*)(P + (32 * tb + r32) * VTP + 16 * ss + 8 * hi);
#pragma unroll
            for (int dvb = 0; dvb < 2; ++dvb) { const bf16x8 bq = *(const LAS bf16x8*)(VT + (64 * dq + 32 * dvb + r32) * VTP + 16 * ss + 8 * hi); acc[dvb] = MFMA32(a, bq, acc[dvb]); } }
#pragma unroll
        for (int r = 0; r < 16; ++r) { float sq = acc[0][r] * acc[0][r] + acc[1][r] * acc[1][r];
            sq += __shfl_xor(sq, 1); sq += __shfl_xor(sq, 2); sq += __shfl_xor(sq, 4); sq += __shfl_xor(sq, 8); sq += __shfl_xor(sq, 16);
            if (r32 == 0) SS[dq * 64 + 32 * tb + crow(r, hi)] = sq; }
        __syncthreads();
        if (tid < 64) RS[tid] = 1.f / sqrtf((SS[tid] + SS[64 + tid] + SS[128 + tid] + SS[192 + tid]) * (1.f / GDV) + RMS_EPS);
        __syncthreads();
#pragma unroll
        for (int dvb = 0; dvb < 2; ++dvb) { const int col = h * 256 + 64 * dq + 32 * dvb + r32; const float gn = g_norm[col];
#pragma unroll
            for (int r = 0; r < 16; ++r) { const int t = 32 * tb + crow(r, hi); const float gv = bf2f(QKVG[(r0 + t) * 3072 + 2048 + col]);
                const float val = acc[dvb][r] * RS[t] * gn * (gv / (1.f + __expf(-gv)));
                O[(r0 + t) * D + col] = (bf16)(cvtpk(val, 0.f) & 0xffffu); } }
        __syncthreads();
    }
}

struct Args { const float* in[17]; float* out; unsigned char* ws; };
__global__ void __launch_bounds__(NTHR, 2) mk_fwd(Args args) {
    extern __shared__ __attribute__((aligned(16))) unsigned char lds[];
    cg::grid_group grid = cg::this_grid();
    Frame F;
    F.lds = (LAS unsigned char*)lds;
    F.G = gridDim.x; { const int bx = blockIdx.x; F.vcu = (F.G % 8 == 0) ? (bx % 8) * (F.G / 8) + bx / 8 : bx; }
#pragma unroll
    for (int i = 0; i < 17; ++i) F.in[i] = args.in[i];
    F.out = args.out; F.ws = args.ws;
    unsigned char* ws = args.ws;
    float* mods = (float*)(ws + WS_MODS);
    bf16* Ub = (bf16*)(ws + WS_U); bf16* BIG = (bf16*)(ws + WS_BIG); bf16* Ob = (bf16*)(ws + WS_O); bf16* ST = (bf16*)(ws + WS_ST);
    float* Y1 = (float*)(ws + WS_BIG); float* Y2 = (float*)(ws + WS_ST); float* CUM = (float*)(ws + WS_CUM); float* DEC = (float*)(ws + WS_DEC2);
#define GSYNC() grid.sync()

    p0a_prologue(F);
    GSYNC();
    mod_rows(F, F.in[0], Ub, mods + 0, mods + 1024);
    GSYNC();

    for (int layer = 0; layer < DEPTH; ++layer) {
        const int j = layer >> 1; const bool gla = (layer & 1) == 0;
        unsigned char* wt = ws + WS_WT + (size_t)layer * WT_LAYER;
        const float* md = mods + (size_t)layer * 2 * 6144;
        if (gla) {
            pg8::Gemm g{Ub, (const bf16*)(wt + WT_IN), M, 3072, D}; pg8::StaticOrder S; S.init(M, 3072, F.G, (int)blockIdx.x);
            pg8::EpiBf16<0> E{BIG, 3072, nullptr, 0, 0, 1.f};
            pg8::gemm_phase<pg8::EpiBf16<0>, pg8::StaticOrder, true, true>(F.lds, g, S, E);
        } else {
            pg8::Gemm g{Ub, (const bf16*)(wt + WT_IN), M, 3072, D}; pg8::StaticOrder S; S.init(M, 3072, F.G, (int)blockIdx.x);
            pg8::EpiBf16<0> E{BIG, D, F.in[12] + (size_t)j * 3072, D, (size_t)M * D, ATT_C2};
            pg8::gemm_phase<pg8::EpiBf16<0>, pg8::StaticOrder, true, true>(F.lds, g, S, E);
        }
        GSYNC();
        if (gla) {
            gla_pass_a(F, Ub, BIG, (const bf16*)(ws + WS_WLR) + (size_t)j * 16 * D, F.in[7] + (size_t)j * 16 * GKT, F.in[8] + (size_t)j * GKT, CUM, DEC, ST);
            GSYNC();
            gla_scan(F, DEC, ST);
            GSYNC();
            gla_pass_c(F, BIG, CUM, ST, F.in[9] + (size_t)j * D, Ob);
        } else {
            attn_phase(F, BIG, BIG + (size_t)M * D, BIG + (size_t)2 * M * D, Ob, F.in[13] + (size_t)j * AH * NREL);
        }
        GSYNC();
        { pg8::Gemm g{Ob, (const bf16*)(wt + WT_OUT), M, D, D}; pg8::StaticOrder S; S.init(M, D, F.G, (int)blockIdx.x);
          pg8::EpiF32 E{Y1, D};
          pg8::gemm_phase<pg8::EpiF32, pg8::StaticOrder, true, true>(F.lds, g, S, E); }
        GSYNC();
        ln_phase(F, layer == 0 ? F.in[0] : F.out, Y1, F.out, Ub, md + 2048, F.in[4] + (size_t)(layer * 2 + 0) * D, F.in[5] + (size_t)(layer * 2 + 0) * D, md + 3072, md + 4096);
        GSYNC();
        { pg8::Gemm g{Ub, (const bf16*)(wt + WT_W1), M, FF, D}; pg8::StaticOrder S; S.init(M, FF, F.G, (int)blockIdx.x);
          pg8::EpiBf16<2> E{BIG, FF, nullptr, 0, 0, 1.f};
          pg8::gemm_phase<pg8::EpiBf16<2>, pg8::StaticOrder, true, true>(F.lds, g, S, E); }
        GSYNC();
        { pg8::Gemm g{BIG, (const bf16*)(wt + WT_W2), M, D, FF}; pg8::StaticOrder S; S.init(M, D, F.G, (int)blockIdx.x);
          pg8::EpiF32 E{Y2, D};
          pg8::gemm_phase<pg8::EpiF32, pg8::StaticOrder, true, true>(F.lds, g, S, E); }
        GSYNC();
        { const bool lastl = layer == DEPTH - 1; const float* mdn = mods + (size_t)(lastl ? layer : layer + 1) * 2 * 6144;
          ln_phase(F, F.out, Y2, F.out, lastl ? (bf16*)nullptr : Ub, md + 5120, F.in[4] + (size_t)(layer * 2 + 1) * D, F.in[5] + (size_t)(layer * 2 + 1) * D, mdn + 0, mdn + 1024); }
        if (layer != DEPTH - 1) GSYNC();
    }
}

extern "C" void kernel_launch(void* const* d_in, const int* in_sizes, int n_in, void* d_out, int out_size, void* d_ws, size_t ws_size, hipStream_t stream) {
    static int grid = 0;
    if (grid == 0) {
        if (n_in != 17 || out_size != M * D || ws_size < WS_END) { fprintf(stderr, "kernel_launch: unexpected shapes (n_in %d out %d ws %zu)\n", n_in, out_size, ws_size); grid = -1; return; }
        int dev = 0, cus = 0, per_cu = 0;
        hipGetDevice(&dev); hipDeviceGetAttribute(&cus, hipDeviceAttributeMultiprocessorCount, dev);
        if (hipFuncSetAttribute((const void*)mk_fwd, hipFuncAttributeMaxDynamicSharedMemorySize, LDS_BYTES) != hipSuccess) { fprintf(stderr, "kernel_launch: hipFuncSetAttribute failed\n"); grid = -1; return; }
        if (hipOccupancyMaxActiveBlocksPerMultiprocessor(&per_cu, (const void*)mk_fwd, NTHR, LDS_BYTES) != hipSuccess || per_cu < 1) { fprintf(stderr, "kernel_launch: occupancy query says %d\n", per_cu); per_cu = 1; }
        (void)hipGetLastError();
        grid = cus * 1;
    }
    if (grid < 0) return;
    Args a{};
    for (int i = 0; i < 17; ++i) a.in[i] = (const float*)d_in[i];
    a.out = (float*)d_out; a.ws = (unsigned char*)d_ws;
    void* kargs[] = {&a};
    hipError_t e = hipLaunchCooperativeKernel((const void*)mk_fwd, dim3(grid), dim3(NTHR), kargs, LDS_BYTES, stream);
    if (e != hipSuccess) fprintf(stderr, "kernel_launch: cooperative launch failed: %s (grid %d)\n", hipGetErrorString(e), grid);
}
```

```cpp
#include <hip/hip_runtime.h>
#include <hip/hip_cooperative_groups.h>
#include <cstdio>
#include <cstdint>
namespace pg8 {
#define PG8_LAS __attribute__((address_space(3)))
typedef unsigned short bf16_t;
typedef short bf16x8 __attribute__((ext_vector_type(8)));
typedef float f32x4 __attribute__((ext_vector_type(4)));
typedef unsigned u32x4 __attribute__((ext_vector_type(4)));
constexpr int BM = 256, BK = 64, HALF = 128, HTB = HALF * BK * 2  , STAGE_BYTES = 8 * HTB, NXCD = 8, WGM = 8;

__host__ __device__ __forceinline__ int lds_byte(int r, int c) { const int st = (r >> 4) * 2 + (c >> 5), rr = r & 15, cc = c & 31, ob = rr * 64 + cc * 2; return st * 1024 + (ob ^ (((ob >> 9) & 1) << 5)); }
__host__ __device__ __forceinline__ void stage_rc(int b, int& R, int& C) { const int st = b / 1024, sb = b % 1024, swz = sb ^ (((sb >> 9) & 1) << 5); R = (st >> 1) * 16 + swz / 64; C = (st & 1) * 32 + (swz % 64) / 2; }
__host__ __device__ __forceinline__ int perm32(int rho) { const int n = rho >> 4, i = rho & 15; return 8 * (i >> 2) + 4 * n + (i & 3); }

struct Unit { int pm, pn; };
struct Gemm { const bf16_t* A; const bf16_t* Bt; int M, N, K; };

struct StaticOrder {
    int nM, nN, nwg, G, c;
    __host__ __device__ void init(int M, int N, int G_, int c_) { nM = M / BM; nN = N / BM; nwg = nM * nN; G = G_; c = c_; }
    __host__ __device__ bool next(int i, Unit& u) const {
        const long L = (long)i * G + c; if (L >= nwg) return false;
        int wgid = (int)L; { const int q = nwg / NXCD, r = nwg % NXCD, xcd = wgid % NXCD, off = wgid / NXCD; wgid = (xcd < r ? xcd * (q + 1) : r * (q + 1) + (xcd - r) * q) + off; }
        const int nig = WGM * nN, gid = wgid / nig, fm = gid * WGM, gsz = (nM - fm) < WGM ? (nM - fm) : WGM;
        u.pm = fm + ((wgid % nig) % gsz); u.pn = (wgid % nig) / gsz; return true;
    }
    __device__ __forceinline__ void a_ready(const Unit&) const {}
    __device__ __forceinline__ void done(const Unit&) const {}
};

__device__ __forceinline__ unsigned cvt_pk_bf16(float lo, float hi) { unsigned r; asm volatile("v_cvt_pk_bf16_f32 %0, %1, %2" : "=v"(r) : "v"(lo), "v"(hi)); return r; }
typedef float f32x2 __attribute__((ext_vector_type(2)));
__device__ __forceinline__ f32x2 gelu_pk(f32x2 v) {
    const f32x2 av = __builtin_elementwise_abs(v), d = av * 0.2316418882f + 1.0f;
    f32x2 t; t.x = __builtin_amdgcn_rcpf(d.x); t.y = __builtin_amdgcn_rcpf(d.y);
    f32x2 q = t * 0.5307027145f + (-0.7265760135f); q = q * t + 0.7107068705f; q = q * t + (-0.142248368f); q = q * t + 0.127414796f; q = q * t;
    const f32x2 s = (v * v) * (-0.72134752044f);
    f32x2 e; e.x = __builtin_amdgcn_exp2f(s.x); e.y = __builtin_amdgcn_exp2f(s.y);
    const f32x2 m = v * (q * e), r = v - m;
    f32x2 o; o.x = v.x < 0.f ? m.x : r.x; o.y = v.y < 0.f ? m.y : r.y; return o;
}

template <int ACT  > struct EpiBf16 {
    static constexpr bool PERM = true, AFTER_DRAIN = false; static_assert(ACT == 0 || ACT == 1 || ACT == 2, "EpiBf16: ACT");
    bf16_t* O; int ldc; const float* bias; int split_cols; size_t split_stride; float scale0;
    __device__ __forceinline__ void operator()(const f32x4 (&acc)[2][2][4][2], const Unit& u, int wr, int wc, int fr, int fq) const {
        const int row0 = u.pm * BM + wr * 64 + fr; int colt = u.pn * BM; bf16_t* base = O;
        float sc = 1.f; if (split_cols) { const int t = colt / split_cols; base += (size_t)t * split_stride; colt -= t * split_cols; if (t == 0) sc = scale0; }
        const int col0 = colt + wc * 32 + 8 * fq, bcol0 = u.pn * BM + wc * 32 + 8 * fq;
        f32x4 bv[2][2];
#pragma unroll
        for (int bj = 0; bj < 2; ++bj)
#pragma unroll
            for (int n = 0; n < 2; ++n) bv[bj][n] = bias ? *(const f32x4*)(bias + bcol0 + bj * HALF + 4 * n) : (f32x4){0.f, 0.f, 0.f, 0.f};
#pragma unroll
        for (int ai = 0; ai < 2; ++ai)
#pragma unroll
            for (int m = 0; m < 4; ++m) { bf16_t* rowp = base + (size_t)(row0 + ai * HALF + m * 16) * ldc + col0;
#pragma unroll
                for (int bj = 0; bj < 2; ++bj) { f32x4 v0 = acc[ai][bj][m][0] + bv[bj][0], v1 = acc[ai][bj][m][1] + bv[bj][1];
                    if (ACT == 1) { f32x2 a = gelu_pk((f32x2){v0[0], v0[1]}), b = gelu_pk((f32x2){v0[2], v0[3]}), c = gelu_pk((f32x2){v1[0], v1[1]}), d = gelu_pk((f32x2){v1[2], v1[3]});
                        v0 = (f32x4){a.x, a.y, b.x, b.y}; v1 = (f32x4){c.x, c.y, d.x, d.y}; }
                    if (ACT == 2) { _Pragma("unroll") for (int e_ = 0; e_ < 4; ++e_) { const float a_ = fmaxf(v0[e_], 0.f), b_ = fmaxf(v1[e_], 0.f); v0[e_] = a_ * a_; v1[e_] = b_ * b_; } }
                    v0 = v0 * sc; v1 = v1 * sc; u32x4 w; w.x = cvt_pk_bf16(v0[0], v0[1]); w.y = cvt_pk_bf16(v0[2], v0[3]); w.z = cvt_pk_bf16(v1[0], v1[1]); w.w = cvt_pk_bf16(v1[2], v1[3]);
                    *(u32x4*)(rowp + bj * HALF) = w; } }
    }
};

struct EpiF32 {
    static constexpr bool PERM = false, AFTER_DRAIN = false;
    float* O; int ldc;
    __device__ __forceinline__ void operator()(const f32x4 (&acc)[2][2][4][2], const Unit& u, int wr, int wc, int fr, int fq) const {
        const int col0 = u.pn * BM + wc * 32 + 4 * fq;
#pragma unroll
        for (int ai = 0; ai < 2; ++ai)
#pragma unroll
            for (int m = 0; m < 4; ++m) { float* rowp = O + (size_t)(u.pm * BM + ai * HALF + wr * 64 + m * 16 + fr) * ldc + col0;
#pragma unroll
                for (int bj = 0; bj < 2; ++bj)
#pragma unroll
                    for (int n = 0; n < 2; ++n) *(f32x4*)(rowp + bj * HALF + n * 16) = acc[ai][bj][m][n]; }
    }
};
template <class Epi, class Sched, bool ALIGN_EPI = false, bool SP2 = false>
__device__ __forceinline__ void gemm_phase(PG8_LAS unsigned char* lds, const Gemm g, const Sched& S, const Epi& E) {
    int tid_ = threadIdx.x; asm volatile("" : "+v"(tid_)); const int tid = tid_, wid = __builtin_amdgcn_readfirstlane(tid >> 6), lane = tid & 63, wr = wid >> 2, wc = wid & 3, fr = lane & 15, fq = lane >> 4;
    const int K = g.K, nt = K / BK;
    unsigned voffA[2], voffB[2];
#pragma unroll
    for (int i = 0; i < 2; ++i) { int R, C; stage_rc(tid * 16 + i * 8192, R, C); const int Rb = Epi::PERM ? ((R & ~31) + perm32(R & 31)) : R;
        voffA[i] = (unsigned)(R * K + C) * 2u; voffB[i] = (unsigned)(Rb * K + C) * 2u; }
    const size_t kstep = (size_t)(BK * 2);
    const size_t hstep = (size_t)HALF * K * 2;
    const size_t tstep = 2 * hstep;
    const unsigned ldsw = (unsigned)wid * 1024u;
    const int aoff = lds_byte(wr * 64 + fr, fq * 8), boff = lds_byte(wc * 32 + fr, fq * 8);
#define PG8_SA(b, h) (((b) * 2 + (h)) * HTB)
#define PG8_SB(b, h) ((4 + (b) * 2 + (h)) * HTB)
#define PG8_STAGE(bufoff, gbase, voff) do { _Pragma("unroll") for (int _i = 0; _i < 2; ++_i) \
        __builtin_amdgcn_global_load_lds((const unsigned*)((const char*)(gbase) + (voff)[_i]), (PG8_LAS unsigned*)(lds + (bufoff) + ldsw + _i * 8192), 16, 0, 0); } while (0)
#define PG8_LDA(dst, b, h) do { _Pragma("unroll") for (int m = 0; m < 4; ++m) _Pragma("unroll") for (int k = 0; k < 2; ++k) dst[m][k] = *(const PG8_LAS bf16x8*)(lds + PG8_SA(b, h) + aoff + m * 2048 + k * 1024); } while (0)
#define PG8_LDB(dst, b, h) do { _Pragma("unroll") for (int n = 0; n < 2; ++n) _Pragma("unroll") for (int k = 0; k < 2; ++k) dst[n][k] = *(const PG8_LAS bf16x8*)(lds + PG8_SB(b, h) + boff + n * 2048 + k * 1024); } while (0)
#define PG8_MMA(ai, bj, At, Bt) do { __builtin_amdgcn_s_setprio(1); _Pragma("unroll") for (int m = 0; m < 4; ++m) _Pragma("unroll") for (int n = 0; n < 2; ++n) _Pragma("unroll") for (int k = 0; k < 2; ++k) \
        acc[ai][bj][m][n] = __builtin_amdgcn_mfma_f32_16x16x32_bf16(Bt[n][k], At[m][k], acc[ai][bj][m][n], 0, 0, 0); __builtin_amdgcn_s_setprio(0); } while (0)
#define PG8_WAIT_V(n) asm volatile("s_waitcnt vmcnt(" #n ")" ::: "memory")
#define PG8_WAIT_L(n) asm volatile("s_waitcnt lgkmcnt(" #n ")" ::: "memory")
#define PG8_BAR __builtin_amdgcn_s_barrier()
#define PG8_SCHED __builtin_amdgcn_sched_barrier(0)
    Unit cur, nxt; int ui = 0;
    if (!S.next(0, cur)) return;
    f32x4 acc[2][2][4][2];
#pragma unroll
    for (int a = 0; a < 2; ++a)
#pragma unroll
        for (int b = 0; b < 2; ++b)
#pragma unroll
            for (int m = 0; m < 4; ++m)
#pragma unroll
                for (int n = 0; n < 2; ++n) acc[a][b][m][n] = (f32x4){0.f, 0.f, 0.f, 0.f};
    bf16x8 At[4][2], B0[2][2], B1[2][2];
    const char* cA = (const char*)g.A + (size_t)cur.pm * tstep; const char* cB = (const char*)g.Bt + (size_t)cur.pn * tstep;
    S.a_ready(cur);
    if constexpr (SP2) {
        PG8_STAGE(PG8_SB(0, 0), cB, voffB); PG8_STAGE(PG8_SB(0, 1), cB + hstep, voffB); PG8_STAGE(PG8_SA(0, 0), cA, voffA); PG8_STAGE(PG8_SA(0, 1), cA + hstep, voffA);
        if (wr == 1) PG8_BAR;
        PG8_WAIT_V(2); PG8_BAR;
        PG8_STAGE(PG8_SB(1, 0), cB + kstep, voffB); PG8_STAGE(PG8_SA(1, 0), cA + kstep, voffA); PG8_STAGE(PG8_SB(1, 1), cB + hstep + kstep, voffB);
        PG8_WAIT_V(6); PG8_BAR;
    } else {
        PG8_STAGE(PG8_SB(0, 0), cB, voffB); PG8_STAGE(PG8_SA(0, 0), cA, voffA); PG8_STAGE(PG8_SB(0, 1), cB + hstep, voffB); PG8_STAGE(PG8_SA(0, 1), cA + hstep, voffA);
        if (wr == 1) PG8_BAR;
        PG8_WAIT_V(4); PG8_BAR;
        PG8_STAGE(PG8_SB(1, 0), cB + kstep, voffB); PG8_STAGE(PG8_SA(1, 0), cA + kstep, voffA); PG8_STAGE(PG8_SB(1, 1), cB + hstep + kstep, voffB);
        PG8_WAIT_V(6); PG8_BAR;
    }
    for (;;) {
        const bool has_next = S.next(ui + 1, nxt);
        const char* nA = has_next ? (const char*)g.A + (size_t)nxt.pm * tstep : cA; const char* nB = has_next ? (const char*)g.Bt + (size_t)nxt.pn * tstep : cB;
        for (int t = 0; t < nt; t += 2) {
            const bool last = (t == nt - 2);
            const char* a1 = cA + (size_t)(t + 1) * kstep;
            const char* a2 = last ? nA : cA + (size_t)(t + 2) * kstep; const char* b2 = last ? nB : cB + (size_t)(t + 2) * kstep;
            const char* a3 = a2 + kstep; const char* b3 = b2 + kstep;
            if (last && has_next) S.a_ready(nxt);
            if constexpr (SP2) {
            PG8_LDB(B0, 0, 0); PG8_LDB(B1, 0, 1); PG8_SCHED; PG8_LDA(At, 0, 0); PG8_STAGE(PG8_SA(1, 1), a1 + hstep, voffA);
            PG8_WAIT_V(8); PG8_WAIT_L(0); PG8_BAR; PG8_MMA(0, 0, At, B0); PG8_MMA(0, 1, At, B1); PG8_BAR; PG8_SCHED;
            PG8_LDA(At, 0, 1); PG8_STAGE(PG8_SB(0, 0), b2, voffB); PG8_STAGE(PG8_SB(0, 1), b2 + hstep, voffB); PG8_STAGE(PG8_SA(0, 0), a2, voffA);
            PG8_WAIT_V(8); PG8_WAIT_L(0); PG8_BAR; PG8_MMA(1, 0, At, B0); PG8_MMA(1, 1, At, B1); PG8_BAR; PG8_SCHED;
            PG8_LDB(B0, 1, 0); PG8_LDB(B1, 1, 1); PG8_SCHED; PG8_LDA(At, 1, 0); PG8_STAGE(PG8_SA(0, 1), a2 + hstep, voffA);
            PG8_WAIT_V(8); PG8_WAIT_L(0); PG8_BAR; PG8_MMA(0, 0, At, B0); PG8_MMA(0, 1, At, B1); PG8_BAR; PG8_SCHED;
            PG8_LDA(At, 1, 1); PG8_STAGE(PG8_SB(1, 0), b3, voffB); PG8_STAGE(PG8_SB(1, 1), b3 + hstep, voffB); PG8_STAGE(PG8_SA(1, 0), a3, voffA);
            PG8_WAIT_V(8); PG8_WAIT_L(0); PG8_BAR; PG8_MMA(1, 0, At, B0); PG8_MMA(1, 1, At, B1); PG8_BAR; PG8_SCHED;
            } else {
            PG8_LDB(B0, 0, 0); PG8_SCHED; PG8_LDA(At, 0, 0); PG8_STAGE(PG8_SA(1, 1), a1 + hstep, voffA);
            PG8_WAIT_L(8); PG8_BAR; PG8_WAIT_L(0); PG8_MMA(0, 0, At, B0); PG8_BAR; PG8_SCHED;
            PG8_LDB(B1, 0, 1); PG8_STAGE(PG8_SB(0, 0), b2, voffB);
            PG8_BAR; PG8_WAIT_L(0); PG8_MMA(0, 1, At, B1); PG8_BAR;
            PG8_LDA(At, 0, 1); PG8_STAGE(PG8_SA(0, 0), a2, voffA);
            PG8_BAR; PG8_WAIT_L(0); PG8_MMA(1, 0, At, B0); PG8_BAR; PG8_SCHED;
            PG8_STAGE(PG8_SB(0, 1), b2 + hstep, voffB);
            PG8_WAIT_V(6); PG8_BAR; PG8_MMA(1, 1, At, B1); PG8_BAR;
            PG8_LDB(B0, 1, 0); PG8_SCHED; PG8_LDA(At, 1, 0); PG8_STAGE(PG8_SA(0, 1), a2 + hstep, voffA);
            PG8_WAIT_L(8); PG8_BAR; PG8_WAIT_L(0); PG8_MMA(0, 0, At, B0); PG8_BAR; PG8_SCHED;
            PG8_LDB(B1, 1, 1); PG8_STAGE(PG8_SB(1, 0), b3, voffB);
            PG8_BAR; PG8_WAIT_L(0); PG8_MMA(0, 1, At, B1); PG8_BAR;
            PG8_LDA(At, 1, 1); PG8_STAGE(PG8_SA(1, 0), a3, voffA);
            PG8_BAR; PG8_WAIT_L(0); PG8_MMA(1, 0, At, B0); PG8_BAR; PG8_SCHED;
            PG8_STAGE(PG8_SB(1, 1), b3 + hstep, voffB);
            PG8_WAIT_V(6); PG8_BAR; PG8_MMA(1, 1, At, B1); PG8_BAR;
            }
        }
        if constexpr (ALIGN_EPI) { if (wr == 0) PG8_BAR; }
        if constexpr (!Epi::AFTER_DRAIN) { E(acc, cur, wr, wc, fr, fq); S.done(cur); }
        if (!has_next) break;
#pragma unroll
        for (int a = 0; a < 2; ++a)
#pragma unroll
            for (int b = 0; b < 2; ++b)
#pragma unroll
                for (int m = 0; m < 4; ++m)
#pragma unroll
                    for (int n = 0; n < 2; ++n) acc[a][b][m][n] = (f32x4){0.f, 0.f, 0.f, 0.f};
        cur = nxt; cA = nA; cB = nB; ++ui;
        if constexpr (ALIGN_EPI) { if (wr == 1) PG8_BAR; }
    }
    PG8_WAIT_V(0);
    if constexpr (!ALIGN_EPI) { if (wr == 0) PG8_BAR; }
    PG8_BAR;
    if constexpr (Epi::AFTER_DRAIN) { E.fused(acc, cur, wr, wc, fr, fq, lds, wid, lane); S.done(cur); }
#undef PG8_SA
#undef PG8_SB
#undef PG8_STAGE
#undef PG8_LDA
#undef PG8_LDB
#undef PG8_MMA
#undef PG8_WAIT_V
#undef PG8_WAIT_L
#undef PG8_BAR
#undef PG8_SCHED
}
}

namespace cg = cooperative_groups;
#define LAS __attribute__((address_space(3)))
#define DI __device__ __forceinline__
typedef unsigned short bf16;
typedef unsigned u32x4 __attribute__((ext_vector_type(4)));
typedef unsigned u32x2 __attribute__((ext_vector_type(2)));
typedef float f32x4 __attribute__((ext_vector_type(4)));
typedef float f32x16 __attribute__((ext_vector_type(16)));
typedef short bf16x8 __attribute__((ext_vector_type(8)));
typedef short s16x4 __attribute__((ext_vector_type(4)));
typedef float f32x2_t __attribute__((ext_vector_type(2)));
typedef __bf16 bf16x2_t __attribute__((ext_vector_type(2)));

constexpr int NWAVES = 8, NTHR = 512;
constexpr int BATCH = 2, SEQ = 8192, D = 1024, M = BATCH * SEQ, FF = 4096, DEPTH = 4;
constexpr int NCH = SEQ / 64;
constexpr int GH = 4, GDK = 128, GDV = 256, GKT = 512, GIN = 3088;
constexpr int AH = 16, NREL = 257;
constexpr float DN_ALPHA = 1.6817928305074290f;
constexpr float LN_EPS = 1e-5f, RMS_EPS = 1e-6f;
constexpr float LOG2E = 1.4426950408889634f;
constexpr float ATT_C2 = 0.125f * LOG2E;
constexpr float GLA_QS = 0.08838834764831845f;

constexpr size_t MiB = 1u << 20;
constexpr size_t WS_CTL = 0;
constexpr size_t WS_MODS = 1 * MiB;
constexpr size_t WS_WLR = 1 * MiB + 512 * 1024;
constexpr size_t WS_WT = 2 * MiB;
constexpr size_t WT_LAYER = 24 * MiB, WT_IN = 0, WT_OUT = 6 * MiB, WT_W1 = 8 * MiB, WT_W2 = 16 * MiB;
constexpr size_t WS_U = 98 * MiB;
constexpr size_t WS_BIG = 130 * MiB;
constexpr size_t WS_O = WS_BIG + 96 * MiB;
constexpr size_t WS_ST = 258 * MiB;
constexpr size_t WS_CUM = 322 * MiB;
constexpr size_t WS_DEC2 = 354 * MiB;
constexpr size_t WS_END = 355 * MiB;

constexpr int RING_BYTES = 131072, LDS_BYTES = 147456;

DI unsigned cvtpk(float lo, float hi) { f32x2_t v = {lo, hi}; bf16x2_t b = __builtin_convertvector(v, bf16x2_t); return __builtin_bit_cast(unsigned, b); }
DI float bf2f(unsigned short h) { return __uint_as_float((unsigned)h << 16); }
DI float bflo(unsigned w) { return __uint_as_float(w << 16); }
DI float bfhi(unsigned w) { return __uint_as_float(w & 0xffff0000u); }
DI int crow(int r, int hi) { return (r & 3) + 8 * (r >> 2) + 4 * hi; }
#define MFMA32(a, b, c) __builtin_amdgcn_mfma_f32_32x32x16_bf16((a), (b), (c), 0, 0, 0)
DI float wave_sum(float v) {
#pragma unroll
    for (int o = 1; o < 64; o <<= 1) v += __shfl_xor(v, o);
    return v;
}

struct Frame {
    LAS unsigned char* lds;
    int vcu, G;
    const float* in[17];
    float* out; unsigned char* ws;
};

DI void p0_transpose_item(const float* W, int ld, int Ncols, int K, bf16* WT, LAS float* scr, int item, int lane) {
    const int nblk = Ncols / 32, kb = item / nblk, nb = item % nblk, k0 = 64 * kb, n0 = 32 * nb;
#pragma unroll 8
    for (int i = 0; i < 32; ++i) { const int kk = 2 * i + (lane >> 5); scr[kk * 33 + (lane & 31)] = W[(size_t)(k0 + kk) * ld + n0 + (lane & 31)]; }
    asm volatile("s_waitcnt lgkmcnt(0)" ::: "memory");
    const int c = lane & 7;
#pragma unroll
    for (int j = 0; j < 4; ++j) { const int n = (lane >> 3) + 8 * j; const LAS float* s = scr + (8 * c) * 33 + n;
        u32x4 o; o.x = cvtpk(s[0 * 33], s[1 * 33]); o.y = cvtpk(s[2 * 33], s[3 * 33]); o.z = cvtpk(s[4 * 33], s[5 * 33]); o.w = cvtpk(s[6 * 33], s[7 * 33]);
        *(u32x4*)(WT + (size_t)(n0 + n) * K + k0 + 8 * c) = o; }
    asm volatile("s_waitcnt lgkmcnt(0)" ::: "memory");
}

DI void p0a_prologue(Frame& F) {
    int tid = threadIdx.x; asm volatile("" : "+v"(tid)); const int lane = tid & 63, wid = __builtin_amdgcn_readfirstlane(tid >> 6); (void)lane; (void)wid;
    const float* c_in = F.in[1]; const float* w_ada = F.in[2]; const float* b_ada = F.in[3];
    float* mods = (float*)(F.ws + WS_MODS);
    LAS float* cact = (LAS float*)(F.lds);
    LAS float* red = (LAS float*)(F.lds + 8192);
    for (int i = tid; i < 2048; i += NTHR) { const float v = c_in[i]; cact[i] = v / (1.f + __expf(-v)); }
    __syncthreads();
    for (int tm = blockIdx.x; tm < 384; tm += F.G) {
        const int layer = tm / 96, cb = tm % 96;
        const float* wp = w_ada + (size_t)layer * D * 6144 + (size_t)(128 * wid) * 6144 + 64 * cb + lane;
        float a0 = 0.f, a1 = 0.f;
#pragma unroll 16
        for (int k = 0; k < 128; ++k) { const float wv = wp[(size_t)k * 6144]; a0 += cact[128 * wid + k] * wv; a1 += cact[1024 + 128 * wid + k] * wv; }
        red[(wid * 2 + 0) * 64 + lane] = a0; red[(wid * 2 + 1) * 64 + lane] = a1;
        __syncthreads();
        if (tid < 128) { const int b = tid >> 6, col = tid & 63; float s = 0.f;
#pragma unroll
            for (int w = 0; w < 8; ++w) s += red[(w * 2 + b) * 64 + col];
            mods[(size_t)(layer * 2 + b) * 6144 + 64 * cb + col] = s + b_ada[layer * 6144 + 64 * cb + col]; }
        __syncthreads();
    }
    { bf16* wlr = (bf16*)(F.ws + WS_WLR); const int gt = blockIdx.x * NTHR + tid;
      if (gt < 32768) { const int j = gt >> 14, n = (gt >> 10) & 15, k = gt & 1023;
          const float v = F.in[6][(size_t)j * D * GIN + (size_t)k * GIN + 3072 + n]; wlr[gt] = (bf16)(cvtpk(v, 0.f) & 0xffffu); (void)n; } }
    LAS float* scr = (LAS float*)(F.lds + 16384 + wid * 12288);
    const int gw = F.vcu * NWAVES + wid, NGW = F.G * NWAVES;
    constexpr int I_IN = 16 * 96, I_OUT = 16 * 32, I_W1 = 16 * 128, I_W2 = 64 * 32, I_LAYER = I_IN + I_OUT + I_W1 + I_W2;
    for (int it = gw; it < DEPTH * I_LAYER; it += NGW) {
        const int layer = it / I_LAYER; int r = it % I_LAYER; const int j = layer >> 1; const bool gla = (layer & 1) == 0;
        unsigned char* wt = F.ws + WS_WT + (size_t)layer * WT_LAYER;
        if (r < I_IN) { if (gla) p0_transpose_item(F.in[6] + (size_t)j * D * GIN, GIN, 3072, D, (bf16*)(wt + WT_IN), scr, r, lane);
                        else p0_transpose_item(F.in[11] + (size_t)j * D * 3072, 3072, 3072, D, (bf16*)(wt + WT_IN), scr, r, lane); continue; }
        r -= I_IN;
        if (r < I_OUT) { p0_transpose_item((gla ? F.in[10] : F.in[14]) + (size_t)j * D * D, D, D, D, (bf16*)(wt + WT_OUT), scr, r, lane); continue; }
        r -= I_OUT;
        if (r < I_W1) { p0_transpose_item(F.in[15] + (size_t)layer * D * FF, FF, FF, D, (bf16*)(wt + WT_W1), scr, r, lane); continue; }
        r -= I_W1;
        p0_transpose_item(F.in[16] + (size_t)layer * FF * D, D, D, FF, (bf16*)(wt + WT_W2), scr, r, lane);
    }
}

DI void mod_rows(Frame& F, const float* x, bf16* U, const float* sh, const float* sc) {
    int tid = threadIdx.x; asm volatile("" : "+v"(tid)); const int lane = tid & 63, wid = __builtin_amdgcn_readfirstlane(tid >> 6); (void)lane; (void)wid;
    const int gw = F.vcu * NWAVES + wid, NGW = F.G * NWAVES;
    for (int m = gw; m < M; m += NGW) {
        const int b = m >> 13; const float* shb = sh + b * 6144; const float* scb = sc + b * 6144;
#pragma unroll
        for (int j = 0; j < 4; ++j) { const int col = 4 * lane + 256 * j;
            const f32x4 v = *(const f32x4*)(x + (size_t)m * D + col), s1 = *(const f32x4*)(scb + col), s0 = *(const f32x4*)(shb + col);
            const f32x4 u = v * (s1 + 1.0f) + s0; u32x2 w; w.x = cvtpk(u[0], u[1]); w.y = cvtpk(u[2], u[3]);
            *(u32x2*)(U + (size_t)m * D + col) = w; }
    }
}

DI void ln_phase(Frame& F, const float* xin, const float* Y, float* xout, bf16* U, const float* gate, const float* lng, const float* lnb, const float* sh, const float* sc) {
    int tid = threadIdx.x; asm volatile("" : "+v"(tid)); const int lane = tid & 63, wid = __builtin_amdgcn_readfirstlane(tid >> 6); (void)lane; (void)wid;
    const int gw = F.vcu * NWAVES + wid, NGW = F.G * NWAVES;
    for (int m = gw; m < M; m += NGW) {
        const int b = m >> 13; const float* gb = gate + b * 6144;
        f32x4 t[4]; float s = 0.f;
#pragma unroll
        for (int j = 0; j < 4; ++j) { const int col = 4 * lane + 256 * j;
            const f32x4 xv = *(const f32x4*)(xin + (size_t)m * D + col), yv = *(const f32x4*)(Y + (size_t)m * D + col), gv = *(const f32x4*)(gb + col);
            t[j] = xv * DN_ALPHA + (gv + 1.0f) * yv; s += (t[j][0] + t[j][1]) + (t[j][2] + t[j][3]); }
        const float mean = wave_sum(s) * (1.f / D); float s2 = 0.f;
#pragma unroll
        for (int j = 0; j < 4; ++j) { t[j] = t[j] - mean; s2 += (t[j][0] * t[j][0] + t[j][1] * t[j][1]) + (t[j][2] * t[j][2] + t[j][3] * t[j][3]); }
        const float rstd = 1.f / sqrtf(wave_sum(s2) * (1.f / D) + LN_EPS);
#pragma unroll
        for (int j = 0; j < 4; ++j) { const int col = 4 * lane + 256 * j;
            const f32x4 o = t[j] * rstd * *(const f32x4*)(lng + col) + *(const f32x4*)(lnb + col);
            *(f32x4*)(xout + (size_t)m * D + col) = o;
            if (U) { const f32x4 u = o * (*(const f32x4*)(sc + b * 6144 + col) + 1.0f) + *(const f32x4*)(sh + b * 6144 + col);
                u32x2 w; w.x = cvtpk(u[0], u[1]); w.y = cvtpk(u[2], u[3]); *(u32x2*)(U + (size_t)m * D + col) = w; } }
    }
}

constexpr int AKP = 72;
constexpr int ATT_OFF_K = 0, ATT_OFF_V = 2 * 64 * AKP * 2, ATT_OFF_B = 4 * 64 * AKP * 2;
DI void attn_phase(Frame& F, const bf16* Q, const bf16* K, const bf16* V, bf16* O, const float* relb) {
    int tid = threadIdx.x; asm volatile("" : "+v"(tid)); const int lane = tid & 63, wid = __builtin_amdgcn_readfirstlane(tid >> 6); (void)lane; (void)wid; const int r32 = lane & 31, hi = lane >> 5;
    LAS bf16* Kl = (LAS bf16*)(F.lds + ATT_OFF_K); LAS bf16* Vl = (LAS bf16*)(F.lds + ATT_OFF_V); LAS float* biasL = (LAS float*)(F.lds + ATT_OFF_B);
    const int srow = tid >> 3, sch = tid & 7;
    for (int u = F.vcu; u < 1024; u += F.G) {
        const int v8 = u & 255, it = u >> 8, bh = (v8 >> 5) * 4 + it, qb = ((v8 & 31) + 8 * it) & 31;
        const int b = bh >> 4, h = bh & 15; const size_t rowbase = (size_t)b * SEQ; const int q0 = qb * 256;
        if (tid < NREL) biasL[tid] = relb[h * NREL + tid] * LOG2E;
        const bf16* Qw = Q + (rowbase + q0 + wid * 32 + r32) * D + h * 64;
        bf16x8 qr[4];
#pragma unroll
        for (int d0 = 0; d0 < 4; ++d0) qr[d0] = *(const bf16x8*)(Qw + d0 * 16 + hi * 8);
        const int cw = 4 * qb + (wid >> 1), tq = (wid & 1) * 32 + r32;
        const int jt0 = (4 * qb - 8) > 0 ? (4 * qb - 8) : 0, jt1 = 4 * qb + 3;
        const bf16* Kg = K + (rowbase + srow) * D + h * 64 + sch * 8; const bf16* Vg = V + (rowbase + srow) * D + h * 64 + sch * 8;
        u32x4 kreg = *(const u32x4*)(Kg + (size_t)jt0 * 64 * D), vreg = *(const u32x4*)(Vg + (size_t)jt0 * 64 * D);
        {   LAS bf16* kd = Kl; LAS bf16* vd = Vl;
            *(LAS u32x4*)(kd + srow * AKP + sch * 8) = kreg;
#pragma unroll
            for (int e = 0; e < 4; ++e) { vd[(sch * 8 + 2 * e) * AKP + srow] = (bf16)(vreg[e] & 0xffffu); vd[(sch * 8 + 2 * e + 1) * AKP + srow] = (bf16)(vreg[e] >> 16); } }
        __syncthreads();
        f32x16 oT[2];
#pragma unroll
        for (int r = 0; r < 16; ++r) { oT[0][r] = 0.f; oT[1][r] = 0.f; }
        float mrun = -1e30f, lrun = 0.f;
        const float biasFar = biasL[256];
        for (int jt = jt0; jt <= jt1; ++jt) {
            const int cur = (jt - jt0) & 1;
            if (jt < jt1) { kreg = *(const u32x4*)(Kg + (size_t)(jt + 1) * 64 * D); vreg = *(const u32x4*)(Vg + (size_t)(jt + 1) * 64 * D); }
            const int dc = cw - jt;
            if (dc >= 0 && dc <= 8) {
                const LAS bf16* kc = Kl + cur * 64 * AKP; const LAS bf16* vc = Vl + cur * 64 * AKP;
                const float binit = (dc >= 3) ? biasFar : 0.f;
                f32x16 p0, p1;
#pragma unroll
                for (int r = 0; r < 16; ++r) { p0[r] = binit; p1[r] = binit; }
#pragma unroll
                for (int d0 = 0; d0 < 4; ++d0) {
                    const bf16x8 a0 = *(const LAS bf16x8*)(kc + r32 * AKP + d0 * 16 + hi * 8);
                    const bf16x8 a1 = *(const LAS bf16x8*)(kc + (32 + r32) * AKP + d0 * 16 + hi * 8);
                    p0 = MFMA32(a0, qr[d0], p0); p1 = MFMA32(a1, qr[d0], p1); }
                if (dc <= 2) {
#pragma unroll
                    for (int r = 0; r < 16; ++r) { const int d = 64 * dc + tq - crow(r, hi); const int i0 = (d < 128 ? d : 128) + 128, d1 = d - 32, i1 = (d1 < 128 ? d1 : 128) + 128;
                        p0[r] += biasL[i0]; p1[r] += biasL[i1]; }
                }
                float mt = fmaxf(p0[0], p1[0]);
#pragma unroll
                for (int r = 1; r < 16; ++r) mt = fmaxf(mt, fmaxf(p0[r], p1[r]));
                mt = fmaxf(mt, __shfl_xor(mt, 32));
                const float mn = fmaxf(mrun, mt), al = __builtin_amdgcn_exp2f(mrun - mn); mrun = mn;
                float ls = 0.f;
#pragma unroll
                for (int r = 0; r < 16; ++r) { p0[r] = __builtin_amdgcn_exp2f(p0[r] - mn); p1[r] = __builtin_amdgcn_exp2f(p1[r] - mn); ls += p0[r] + p1[r]; oT[0][r] *= al; oT[1][r] *= al; }
                lrun = lrun * al + ls;
                bf16x8 pw[2][2];
#pragma unroll
                for (int s = 0; s < 2; ++s) {
                    u32x4 w0, w1;
                    w0.x = cvtpk(p0[8 * s + 0], p0[8 * s + 1]); w0.y = cvtpk(p0[8 * s + 2], p0[8 * s + 3]); w0.z = cvtpk(p0[8 * s + 4], p0[8 * s + 5]); w0.w = cvtpk(p0[8 * s + 6], p0[8 * s + 7]);
                    w1.x = cvtpk(p1[8 * s + 0], p1[8 * s + 1]); w1.y = cvtpk(p1[8 * s + 2], p1[8 * s + 3]); w1.z = cvtpk(p1[8 * s + 4], p1[8 * s + 5]); w1.w = cvtpk(p1[8 * s + 6], p1[8 * s + 7]);
                    pw[0][s] = __builtin_bit_cast(bf16x8, w0); pw[1][s] = __builtin_bit_cast(bf16x8, w1); }
#pragma unroll
                for (int d0 = 0; d0 < 2; ++d0)
#pragma unroll
                    for (int hf = 0; hf < 2; ++hf)
#pragma unroll
                        for (int s = 0; s < 2; ++s) {
                            const LAS bf16* vp = vc + (32 * d0 + r32) * AKP + 32 * hf + 16 * s + 4 * hi;
                            const s16x4 lo = *(const LAS s16x4*)(vp), hh = *(const LAS s16x4*)(vp + 8);
                            const bf16x8 af = __builtin_shufflevector(lo, hh, 0, 1, 2, 3, 4, 5, 6, 7);
                            oT[d0] = MFMA32(af, pw[hf][s], oT[d0]); }
            }
            if (jt < jt1) { LAS bf16* kd = Kl + (cur ^ 1) * 64 * AKP; LAS bf16* vd = Vl + (cur ^ 1) * 64 * AKP;
                *(LAS u32x4*)(kd + srow * AKP + sch * 8) = kreg;
#pragma unroll
                for (int e = 0; e < 4; ++e) { vd[(sch * 8 + 2 * e) * AKP + srow] = (bf16)(vreg[e] & 0xffffu); vd[(sch * 8 + 2 * e + 1) * AKP + srow] = (bf16)(vreg[e] >> 16); } }
            __syncthreads();
        }
        const float lt = lrun + __shfl_xor(lrun, 32), inv = 1.f / lt;
        bf16* Ow = O + (rowbase + q0 + wid * 32 + r32) * D + h * 64;
#pragma unroll
        for (int d0 = 0; d0 < 2; ++d0)
#pragma unroll
            for (int g = 0; g < 4; ++g) { u32x2 w; w.x = cvtpk(oT[d0][4 * g] * inv, oT[d0][4 * g + 1] * inv); w.y = cvtpk(oT[d0][4 * g + 2] * inv, oT[d0][4 * g + 3] * inv);
                *(u32x2*)(Ow + 32 * d0 + 8 * g + 4 * hi) = w; }
    }
}

DI float log_sigmoid(float z) { return fminf(z, 0.f) - __logf(1.f + __expf(-fabsf(z))); }
constexpr int VTP = 72, QKP = 136;
DI void stage_vt(Frame& F, int tid, const bf16* QKVG, size_t r0, int h, LAS bf16* VT) {
#pragma unroll
    for (int i = 0; i < 4; ++i) { const int idx = tid + NTHR * i, s = idx >> 5, ch = idx & 31;
        const u32x4 v = *(const u32x4*)(QKVG + (r0 + s) * 3072 + 1024 + h * 256 + ch * 8);
#pragma unroll
        for (int e = 0; e < 4; ++e) { VT[(ch * 8 + 2 * e) * VTP + s] = (bf16)(v[e] & 0xffffu); VT[(ch * 8 + 2 * e + 1) * VTP + s] = (bf16)(v[e] >> 16); } }
}
constexpr int GA_OFF_PART = 0, GA_OFF_GK = 16384, GA_OFF_KET = 20480, GA_OFF_VT = 94208;
DI void gla_pass_a(Frame& F, const bf16* U, const bf16* QKVG, const bf16* wlr, const float* w_gk2, const float* b_gk, float* CUM, float* DEC, bf16* ST) {
    int tid = threadIdx.x; asm volatile("" : "+v"(tid)); const int lane = tid & 63, wid = __builtin_amdgcn_readfirstlane(tid >> 6); (void)lane; (void)wid; const int r32 = lane & 31, hi = lane >> 5;
    LAS float* part = (LAS float*)(F.lds + GA_OFF_PART); LAS float* GK = (LAS float*)(F.lds + GA_OFF_GK);
    LAS bf16* KET = (LAS bf16*)(F.lds + GA_OFF_KET); LAS bf16* VT = (LAS bf16*)(F.lds + GA_OFF_VT);
    for (int u = F.vcu; u < BATCH * NCH; u += F.G) {
        const int b = u >> 7, n = u & 127; const size_t r0 = (size_t)b * SEQ + 64 * n;
        { const int rb = wid & 1, kq = wid >> 1;
          const bf16* Ur = U + (r0 + 32 * rb + r32) * D + kq * 256 + hi * 8; const bf16* Wl = wlr + (r32 & 15) * D + kq * 256 + hi * 8;
          f32x16 acc;
#pragma unroll
          for (int r = 0; r < 16; ++r) acc[r] = 0.f;
#pragma unroll 4
          for (int ks = 0; ks < 16; ++ks) { const bf16x8 a = *(const bf16x8*)(Ur + 16 * ks); bf16x8 bq = *(const bf16x8*)(Wl + 16 * ks);
              if (r32 >= 16) bq = (bf16x8){0, 0, 0, 0, 0, 0, 0, 0};
              acc = MFMA32(a, bq, acc); }
          if (r32 < 16) {
#pragma unroll
              for (int r = 0; r < 16; ++r) part[(wid * 32 + crow(r, hi)) * 16 + r32] = acc[r]; }
        }
        __syncthreads();
#pragma unroll
        for (int i = 0; i < 2; ++i) { const int o = tid + NTHR * i, row = o >> 4, j = o & 15, rb = row >> 5; float s = 0.f;
#pragma unroll
            for (int kq = 0; kq < 4; ++kq) s += part[((kq * 2 + rb) * 32 + (row & 31)) * 16 + j];
            GK[row * 16 + j] = s; }
        __syncthreads();
        { const int c = tid; float w2[16];
#pragma unroll
          for (int j = 0; j < 16; ++j) w2[j] = w_gk2[j * GKT + c];
          const float bg = b_gk[c]; float cum = 0.f; float cumv[64];
#pragma unroll
          for (int t = 0; t < 64; ++t) {
              const f32x4 g0 = *(const LAS f32x4*)(GK + t * 16), g1 = *(const LAS f32x4*)(GK + t * 16 + 4), g2 = *(const LAS f32x4*)(GK + t * 16 + 8), g3 = *(const LAS f32x4*)(GK + t * 16 + 12);
              float z = bg;
              z += g0[0] * w2[0] + g0[1] * w2[1] + g0[2] * w2[2] + g0[3] * w2[3];
              z += g1[0] * w2[4] + g1[1] * w2[5] + g1[2] * w2[6] + g1[3] * w2[7];
              z += g2[0] * w2[8] + g2[1] * w2[9] + g2[2] * w2[10] + g2[3] * w2[11];
              z += g3[0] * w2[12] + g3[1] * w2[13] + g3[2] * w2[14] + g3[3] * w2[15];
              cum += log_sigmoid(z) * (1.f / 16.f); cumv[t] = cum; CUM[(r0 + t) * GKT + c] = cum; }
          DEC[(size_t)u * GKT + c] = __expf(cum);
          const bf16* kp = QKVG + r0 * 3072 + 512 + c;
#pragma unroll
          for (int t8 = 0; t8 < 8; ++t8) { float ke[8];
#pragma unroll
              for (int e = 0; e < 8; ++e) { const int t = 8 * t8 + e; ke[e] = bf2f(kp[(size_t)t * 3072]) * __expf(cum - cumv[t]); }
              u32x4 w; w.x = cvtpk(ke[0], ke[1]); w.y = cvtpk(ke[2], ke[3]); w.z = cvtpk(ke[4], ke[5]); w.w = cvtpk(ke[6], ke[7]);
              *(LAS u32x4*)(KET + c * VTP + 8 * t8) = w; }
        }
        for (int h = 0; h < GH; ++h) {
            stage_vt(F, tid, QKVG, r0, h, VT);
            __syncthreads();
            f32x16 acc[4];
#pragma unroll
            for (int nb = 0; nb < 4; ++nb)
#pragma unroll
                for (int r = 0; r < 16; ++r) acc[nb][r] = 0.f;
#pragma unroll
            for (int ks = 0; ks < 4; ++ks) { const bf16x8 a = *(const LAS bf16x8*)(VT + (32 * wid + r32) * VTP + 16 * ks + 8 * hi);
#pragma unroll
                for (int nb = 0; nb < 4; ++nb) { const bf16x8 bq = *(const LAS bf16x8*)(KET + (h * 128 + 32 * nb + r32) * VTP + 16 * ks + 8 * hi); acc[nb] = MFMA32(a, bq, acc[nb]); } }
            bf16* sp = ST + ((size_t)((b * GH + h) * NCH + n) * GDV + 32 * wid) * GDK;
#pragma unroll
            for (int nb = 0; nb < 4; ++nb)
#pragma unroll
                for (int r = 0; r < 16; ++r) sp[(size_t)crow(r, hi) * GDK + 32 * nb + r32] = (bf16)(cvtpk(acc[nb][r], 0.f) & 0xffffu);
            __syncthreads();
        }
    }
}
DI void gla_scan(Frame& F, const float* DEC, bf16* ST) {
    int tid = threadIdx.x; asm volatile("" : "+v"(tid)); const int lane = tid & 63, wid = __builtin_amdgcn_readfirstlane(tid >> 6); (void)lane; (void)wid;
    const int gt = F.vcu * NTHR + tid, NGT = F.G * NTHR;
    for (int p = gt; p < 8 * 16384; p += NGT) {
        const int bh = p >> 14, e = (p & 16383) * 2, dk = e & 127, b = bh >> 2, h = bh & 3;
        unsigned* base = (unsigned*)(ST + (size_t)bh * NCH * 32768 + e);
        const float* dbase = DEC + (size_t)b * NCH * GKT + h * 128 + dk;
        float s0 = 0.f, s1 = 0.f;
        for (int n0 = 0; n0 < NCH; n0 += 8) {
            unsigned kv[8]; f32x2_t dd[8];
#pragma unroll
            for (int i = 0; i < 8; ++i) { kv[i] = base[(size_t)(n0 + i) * 16384]; dd[i] = *(const f32x2_t*)(dbase + (size_t)(n0 + i) * GKT); }
#pragma unroll
            for (int i = 0; i < 8; ++i) { base[(size_t)(n0 + i) * 16384] = cvtpk(s0, s1); s0 = dd[i][0] * s0 + bflo(kv[i]); s1 = dd[i][1] * s1 + bfhi(kv[i]); }
        }
    }
}
constexpr int GC_OFF_QF = 0, GC_OFF_QB = 17408, GC_OFF_KN = 34816, GC_OFF_KP = 52224, GC_OFF_VT = 69632, GC_OFF_P = 106496, GC_OFF_SS = 115712, GC_OFF_RS = 116736;
DI void gla_pass_c(Frame& F, const bf16* QKVG, const float* CUM, const bf16* ST, const float* g_norm, bf16* O) {
    int tid = threadIdx.x; asm volatile("" : "+v"(tid)); const int lane = tid & 63, wid = __builtin_amdgcn_readfirstlane(tid >> 6); (void)lane; (void)wid; const int r32 = lane & 31, hi = lane >> 5;
    LAS bf16* QF = (LAS bf16*)(F.lds + GC_OFF_QF); LAS bf16* QB = (LAS bf16*)(F.lds + GC_OFF_QB); LAS bf16* KN = (LAS bf16*)(F.lds + GC_OFF_KN); LAS bf16* KP = (LAS bf16*)(F.lds + GC_OFF_KP);
    LAS bf16* VT = (LAS bf16*)(F.lds + GC_OFF_VT); LAS bf16* P = (LAS bf16*)(F.lds + GC_OFF_P); LAS float* SS = (LAS float*)(F.lds + GC_OFF_SS); LAS float* RS = (LAS float*)(F.lds + GC_OFF_RS);
    for (int u = F.vcu; u < 8 * NCH; u += F.G) {
        const int bh = u >> 7, n = u & 127, b = bh >> 2, h = bh & 3; const size_t r0 = (size_t)b * SEQ + 64 * n;
        const int tb = wid & 1, dq = wid >> 1;
        bf16x8 Sfr[2][8];
        { const bf16* sp = ST + ((size_t)(bh * NCH + n) * GDV + 64 * dq + r32) * GDK + 8 * hi;
#pragma unroll
          for (int dvb = 0; dvb < 2; ++dvb)
#pragma unroll
              for (int ks = 0; ks < 8; ++ks) Sfr[dvb][ks] = *(const bf16x8*)(sp + (size_t)(32 * dvb) * GDK + 16 * ks); }
#pragma unroll
        for (int i = 0; i < 2; ++i) { const int idx = tid + NTHR * i, t = idx >> 4, c8 = idx & 15;
            const u32x4 q8 = *(const u32x4*)(QKVG + (r0 + t) * 3072 + h * 128 + c8 * 8), k8 = *(const u32x4*)(QKVG + (r0 + t) * 3072 + 512 + h * 128 + c8 * 8);
            const f32x4 c0 = *(const f32x4*)(CUM + (r0 + t) * GKT + h * 128 + c8 * 8), c1 = *(const f32x4*)(CUM + (r0 + t) * GKT + h * 128 + c8 * 8 + 4);
            float qf[8], qb[8], kn[8], kp[8];
#pragma unroll
            for (int e = 0; e < 8; ++e) { const float cm = e < 4 ? c0[e & 3] : c1[e & 3]; const float ep = __expf(cm), en = __expf(-cm);
                const unsigned qw = q8[e >> 1], kw = k8[e >> 1]; const float qv = ((e & 1) ? bfhi(qw) : bflo(qw)) * GLA_QS, kv = (e & 1) ? bfhi(kw) : bflo(kw);
                qf[e] = qv * ep; qb[e] = qv * en; kn[e] = kv * en; kp[e] = kv * ep; }
            u32x4 w;
            w.x = cvtpk(qf[0], qf[1]); w.y = cvtpk(qf[2], qf[3]); w.z = cvtpk(qf[4], qf[5]); w.w = cvtpk(qf[6], qf[7]); *(LAS u32x4*)(QF + t * QKP + c8 * 8) = w;
            w.x = cvtpk(qb[0], qb[1]); w.y = cvtpk(qb[2], qb[3]); w.z = cvtpk(qb[4], qb[5]); w.w = cvtpk(qb[6], qb[7]); *(LAS u32x4*)(QB + t * QKP + c8 * 8) = w;
            w.x = cvtpk(kn[0], kn[1]); w.y = cvtpk(kn[2], kn[3]); w.z = cvtpk(kn[4], kn[5]); w.w = cvtpk(kn[6], kn[7]); *(LAS u32x4*)(KN + t * QKP + c8 * 8) = w;
            w.x = cvtpk(kp[0], kp[1]); w.y = cvtpk(kp[2], kp[3]); w.z = cvtpk(kp[4], kp[5]); w.w = cvtpk(kp[6], kp[7]); *(LAS u32x4*)(KP + t * QKP + c8 * 8) = w; }
        stage_vt(F, tid, QKVG, r0, h, VT);
        __syncthreads();
        { const int sb = wid & 1, tb2 = (wid >> 1) & 1, var = wid >> 2;
          const LAS bf16* Aop = (var ? KP : KN) + (32 * sb + r32) * QKP + 8 * hi; const LAS bf16* Bop = (var ? QB : QF) + (32 * tb2 + r32) * QKP + 8 * hi;
          f32x16 acc;
#pragma unroll
          for (int r = 0; r < 16; ++r) acc[r] = 0.f;
#pragma unroll
          for (int ks = 0; ks < 8; ++ks) { const bf16x8 a = *(const LAS bf16x8*)(Aop + 16 * ks), bq = *(const LAS bf16x8*)(Bop + 16 * ks); acc = MFMA32(a, bq, acc); }
          const int t = 32 * tb2 + r32;
#pragma unroll
          for (int r = 0; r < 16; ++r) { const int s = 32 * sb + crow(r, hi); const bool take = var ? (s > t) : (s <= t);
              if (take) P[t * VTP + s] = (bf16)(cvtpk(acc[r], 0.f) & 0xffffu); }
        }
        __syncthreads();
        f32x16 acc[2];
#pragma unroll
        for (int r = 0; r < 16; ++r) { acc[0][r] = 0.f; acc[1][r] = 0.f; }
#pragma unroll
        for (int ks = 0; ks < 8; ++ks) { const bf16x8 a = *(const LAS bf16x8*)(QF + (32 * tb + r32) * QKP + 16 * ks + 8 * hi);
            acc[0] = MFMA32(a, Sfr[0][ks], acc[0]); acc[1] = MFMA32(a, Sfr[1][ks], acc[1]); }
#pragma unroll
        for (int ss = 0; ss < 4; ++ss) { const bf16x8 a = *(const LAS bf16x8*)(P + (32 * tb + r32) * VTP + 16 * ss + 8 * hi);
#pragma unroll
            for (int dvb = 0; dvb < 2; ++dvb) { const bf16x8 bq = *(const LAS bf16x8*)(VT + (64 * dq + 32 * dvb + r32) * VTP + 16 * ss + 8 * hi); acc[dvb] = MFMA32(a, bq, acc[dvb]); } }
#pragma unroll
        for (int r = 0; r < 16; ++r) { float sq = acc[0][r] * acc[0][r] + acc[1][r] * acc[1][r];
            sq += __shfl_xor(sq, 1); sq += __shfl_xor(sq, 2); sq += __shfl_xor(sq, 4); sq += __shfl_xor(sq, 8); sq += __shfl_xor(sq, 16);
            if (r32 == 0) SS[dq * 64 + 32 * tb + crow(r, hi)] = sq; }
        __syncthreads();
        if (tid < 64) RS[tid] = 1.f / sqrtf((SS[tid] + SS[64 + tid] + SS[128 + tid] + SS[192 + tid]) * (1.f / GDV) + RMS_EPS);
        __syncthreads();
#pragma unroll
        for (int dvb = 0; dvb < 2; ++dvb) { const int col = h * 256 + 64 * dq + 32 * dvb + r32; const float gn = g_norm[col];
#pragma unroll
            for (int r = 0; r < 16; ++r) { const int t = 32 * tb + crow(r, hi); const float gv = bf2f(QKVG[(r0 + t) * 3072 + 2048 + col]);
                const float val = acc[dvb][r] * RS[t] * gn * (gv / (1.f + __expf(-gv)));
                O[(r0 + t) * D + col] = (bf16)(cvtpk(val, 0.f) & 0xffffu); } }
        __syncthreads();
    }
}

#define RLX_AGENT __ATOMIC_RELAXED, __HIP_MEMORY_SCOPE_AGENT
#define LDS_WAIT() asm volatile("s_waitcnt lgkmcnt(0)" ::: "memory")
#define VM_WAIT() asm volatile("s_waitcnt vmcnt(0)" ::: "memory")
__device__ __forceinline__ unsigned long long rt() { return __builtin_amdgcn_s_memrealtime(); }
#define XB_TMO      128
#define XB_XCNT(j)  (256  + 64 * (j))
#define XB_XSUB(j)  (1280 + 64 * (j))
#define XB_XGEN(j)  (2304 + 64 * (j))
#define XB_TOP      3328
#define XB_TOPGEN   3392
#define XCD_BAR_WORDS 3456
#define XB_SPIN_CAP (1u << 18)

__device__ __forceinline__ unsigned xb_ld(unsigned* p)              { return __hip_atomic_load(p, __ATOMIC_RELAXED, __HIP_MEMORY_SCOPE_AGENT); }
__device__ __forceinline__ unsigned xb_add(unsigned* p, unsigned v) { return __hip_atomic_fetch_add(p, v, __ATOMIC_RELAXED, __HIP_MEMORY_SCOPE_AGENT); }
__device__ __forceinline__ unsigned xb_xcc_id() { return (unsigned)__builtin_amdgcn_s_getreg((3 << 11) | 20) & 0xFu; }
#define XB_SPIN(cond, bar) do { unsigned _sp = 0; while (cond) { __builtin_amdgcn_s_sleep(1); \
    if ((++_sp & 255u) == 0u) { if (xb_ld(&(bar)[XB_TMO])) break; if (_sp > XB_SPIN_CAP) { atomicAdd(&(bar)[XB_TMO], 1u); break; } } } } while (0)

struct XcdBarrier {
    unsigned* bar; unsigned x;
    volatile LAS unsigned* st;
};

__device__ __forceinline__ XcdBarrier xcd_barrier_post(unsigned* bar, volatile LAS unsigned* st) {
    XcdBarrier b; b.bar = bar; b.x = xb_xcc_id(); b.st = st;
    if (threadIdx.x == 0) (void)xb_add(&bar[XB_XCNT(b.x)], 1u);
    return b;
}
__device__ __forceinline__ void xcd_barrier_complete(unsigned* bar, unsigned x, unsigned& nloc, unsigned& nx) {
    const unsigned G = gridDim.x * gridDim.y * gridDim.z;
    unsigned sum, cnt, mine, sp = 0u;
    for (;;) {
        sum = 0u; cnt = 0u; mine = 0u;
#pragma unroll
        for (unsigned j = 0; j < 16; ++j) { const unsigned c = xb_ld(&bar[XB_XCNT(j)]); sum += c; cnt += (c > 0u) ? 1u : 0u; mine = (j == x) ? c : mine; }
        if (sum == G) break;
        __builtin_amdgcn_s_sleep(1);
        if ((++sp & 255u) == 0u) { if (xb_ld(&bar[XB_TMO])) break; if (sp > XB_SPIN_CAP) { atomicAdd(&bar[XB_TMO], 1u); break; } }
    }
    nloc = mine > 0u ? mine : 1u; nx = cnt > 0u ? cnt : 1u;
}

__device__ __forceinline__ void xcd_barrier(const XcdBarrier& b) {
    asm volatile("s_waitcnt vmcnt(0)" ::: "memory");
    __syncthreads();
    if (threadIdx.x == 0) {
        unsigned* bar = b.bar;
        __builtin_amdgcn_s_waitcnt(0);
        unsigned nloc = b.st[0], nx = b.st[1];
        if (nloc == 0u) { xcd_barrier_complete(bar, b.x, nloc, nx); b.st[0] = nloc; b.st[1] = nx; }
        const unsigned old = xb_add(&bar[XB_XSUB(b.x)], 1u);
        const unsigned gen = old / nloc;
        if (old + 1u == (gen + 1u) * nloc) {
            __builtin_amdgcn_fence(__ATOMIC_RELEASE, "agent");
            asm volatile("s_waitcnt vmcnt(0)" ::: "memory");
            const unsigned og = xb_add(&bar[XB_TOP], 1u);
            const unsigned tg = og / nx;
            if (og + 1u == (tg + 1u) * nx) xb_add(&bar[XB_TOPGEN], 1u);
            else XB_SPIN(xb_ld(&bar[XB_TOPGEN]) == tg, bar);
            __builtin_amdgcn_fence(__ATOMIC_ACQUIRE, "agent");
            xb_add(&bar[XB_XGEN(b.x)], 1u);
            asm volatile("s_waitcnt vmcnt(0)" ::: "memory");
        } else {
            XB_SPIN(xb_ld(&bar[XB_XGEN(b.x)]) == gen, bar);
            __builtin_amdgcn_fence(__ATOMIC_ACQUIRE, "agent");
            asm volatile("s_waitcnt vmcnt(0)" ::: "memory");
        }
    }
    __syncthreads();
}

struct Args { const float* in[17]; float* out; unsigned char* ws; };
__global__ void __launch_bounds__(NTHR, 2) mk_fwd(Args args) {
    extern __shared__ __attribute__((aligned(16))) unsigned char lds[];
    cg::grid_group grid = cg::this_grid();
    Frame F;
    F.lds = (LAS unsigned char*)lds;
    F.G = gridDim.x; { const int bx = blockIdx.x; F.vcu = (F.G % 8 == 0) ? (bx % 8) * (F.G / 8) + bx / 8 : bx; }
#pragma unroll
    for (int i = 0; i < 17; ++i) F.in[i] = args.in[i];
    F.out = args.out; F.ws = args.ws;
    unsigned char* ws = args.ws;
    float* mods = (float*)(ws + WS_MODS);
    bf16* Ub = (bf16*)(ws + WS_U); bf16* BIG = (bf16*)(ws + WS_BIG); bf16* Ob = (bf16*)(ws + WS_O); bf16* ST = (bf16*)(ws + WS_ST);
    float* Y1 = (float*)(ws + WS_BIG); float* Y2 = (float*)(ws + WS_ST); float* CUM = (float*)(ws + WS_CUM); float* DEC = (float*)(ws + WS_DEC2);
    unsigned* barw = (unsigned*)(ws + WS_CTL) + 64;
    volatile LAS unsigned* bst = (volatile LAS unsigned*)(F.lds + RING_BYTES + 64);
    if (threadIdx.x < 2) bst[threadIdx.x] = 0u;
    if (blockIdx.x == 0) { for (int i = threadIdx.x; i < XCD_BAR_WORDS; i += NTHR) barw[i] = 0u; }
    __syncthreads();
    XcdBarrier xbar; xbar.bar = barw; xbar.x = 0; xbar.st = bst;
#define GSYNC() xcd_barrier(xbar)

    p0a_prologue(F);
    grid.sync();
    xbar = xcd_barrier_post(barw, bst);
    mod_rows(F, F.in[0], Ub, mods + 0, mods + 1024);
    GSYNC();

    for (int layer = 0; layer < DEPTH; ++layer) {
        const int j = layer >> 1; const bool gla = (layer & 1) == 0;
        unsigned char* wt = ws + WS_WT + (size_t)layer * WT_LAYER;
        const float* md = mods + (size_t)layer * 2 * 6144;
        if (gla) {
            pg8::Gemm g{Ub, (const bf16*)(wt + WT_IN), M, 3072, D}; pg8::StaticOrder S; S.init(M, 3072, F.G, (int)blockIdx.x);
            pg8::EpiBf16<0> E{BIG, 3072, nullptr, 0, 0, 1.f};
            pg8::gemm_phase<pg8::EpiBf16<0>, pg8::StaticOrder, true, true>(F.lds, g, S, E);
        } else {
            pg8::Gemm g{Ub, (const bf16*)(wt + WT_IN), M, 3072, D}; pg8::StaticOrder S; S.init(M, 3072, F.G, (int)blockIdx.x);
            pg8::EpiBf16<0> E{BIG, D, F.in[12] + (size_t)j * 3072, D, (size_t)M * D, ATT_C2};
            pg8::gemm_phase<pg8::EpiBf16<0>, pg8::StaticOrder, true, true>(F.lds, g, S, E);
        }
        GSYNC();
        if (gla) {
            gla_pass_a(F, Ub, BIG, (const bf16*)(ws + WS_WLR) + (size_t)j * 16 * D, F.in[7] + (size_t)j * 16 * GKT, F.in[8] + (size_t)j * GKT, CUM, DEC, ST);
            GSYNC();
            gla_scan(F, DEC, ST);
            GSYNC();
            gla_pass_c(F, BIG, CUM, ST, F.in[9] + (size_t)j * D, Ob);
        } else {
            attn_phase(F, BIG, BIG + (size_t)M * D, BIG + (size_t)2 * M * D, Ob, F.in[13] + (size_t)j * AH * NREL);
        }
        GSYNC();
        { pg8::Gemm g{Ob, (const bf16*)(wt + WT_OUT), M, D, D}; pg8::StaticOrder S; S.init(M, D, F.G, (int)blockIdx.x);
          pg8::EpiF32 E{Y1, D};
          pg8::gemm_phase<pg8::EpiF32, pg8::StaticOrder, true, true>(F.lds, g, S, E); }
        GSYNC();
        ln_phase(F, layer == 0 ? F.in[0] : F.out, Y1, F.out, Ub, md + 2048, F.in[4] + (size_t)(layer * 2 + 0) * D, F.in[5] + (size_t)(layer * 2 + 0) * D, md + 3072, md + 4096);
        GSYNC();
        { pg8::Gemm g{Ub, (const bf16*)(wt + WT_W1), M, FF, D}; pg8::StaticOrder S; S.init(M, FF, F.G, (int)blockIdx.x);
          pg8::EpiBf16<2> E{BIG, FF, nullptr, 0, 0, 1.f};
          pg8::gemm_phase<pg8::EpiBf16<2>, pg8::StaticOrder, true, true>(F.lds, g, S, E); }
        GSYNC();
        { pg8::Gemm g{BIG, (const bf16*)(wt + WT_W2), M, D, FF}; pg8::StaticOrder S; S.init(M, D, F.G, (int)blockIdx.x);
          pg8::EpiF32 E{Y2, D};
          pg8::gemm_phase<pg8::EpiF32, pg8::StaticOrder, true, true>(F.lds, g, S, E); }
        GSYNC();
        { const bool lastl = layer == DEPTH - 1; const float* mdn = mods + (size_t)(lastl ? layer : layer + 1) * 2 * 6144;
          ln_phase(F, F.out, Y2, F.out, lastl ? (bf16*)nullptr : Ub, md + 5120, F.in[4] + (size_t)(layer * 2 + 1) * D, F.in[5] + (size_t)(layer * 2 + 1) * D, mdn + 0, mdn + 1024); }
        if (layer != DEPTH - 1) GSYNC();
    }
}

extern "C" void kernel_launch(void* const* d_in, const int* in_sizes, int n_in, void* d_out, int out_size, void* d_ws, size_t ws_size, hipStream_t stream) {
    static int grid = 0;
    if (grid == 0) {
        if (n_in != 17 || out_size != M * D || ws_size < WS_END) { fprintf(stderr, "kernel_launch: unexpected shapes (n_in %d out %d ws %zu)\n", n_in, out_size, ws_size); grid = -1; return; }
        int dev = 0, cus = 0, per_cu = 0;
        hipGetDevice(&dev); hipDeviceGetAttribute(&cus, hipDeviceAttributeMultiprocessorCount, dev);
        if (hipFuncSetAttribute((const void*)mk_fwd, hipFuncAttributeMaxDynamicSharedMemorySize, LDS_BYTES) != hipSuccess) { fprintf(stderr, "kernel_launch: hipFuncSetAttribute failed\n"); grid = -1; return; }
        if (hipOccupancyMaxActiveBlocksPerMultiprocessor(&per_cu, (const void*)mk_fwd, NTHR, LDS_BYTES) != hipSuccess || per_cu < 1) { fprintf(stderr, "kernel_launch: occupancy query says %d\n", per_cu); per_cu = 1; }
        (void)hipGetLastError();
        grid = cus * 1;
    }
    if (grid < 0) return;
    Args a{};
    for (int i = 0; i < 17; ++i) a.in[i] = (const float*)d_in[i];
    a.out = (float*)d_out; a.ws = (unsigned char*)d_ws;
    void* kargs[] = {&a};
    hipError_t e = hipLaunchCooperativeKernel((const void*)mk_fwd, dim3(grid), dim3(NTHR), kargs, LDS_BYTES, stream);
    if (e != hipSuccess) fprintf(stderr, "kernel_launch: cooperative launch failed: %s (grid %d)\n", hipGetErrorString(e), grid);
}
```
